# Optimizing an MI355X kernel written in HIP

```python
import jax, jax.numpy as jnp
from jax import lax
import numpy as np

D_MODEL = 1024
BATCH = 2
SEQ = 16384
DEPTH = 1

A_HEADS = 8
A_KV_HEADS = 2
A_HEAD_DIM = 64
WINDOW = 128
BLOCK = 128
B_HEADS = 8
B_NOPE_DIM = 64
B_ROPE_DIM = 32
B_V_DIM = 64
B_Q_RANK = 768
B_KV_RANK = 256
ROPE_THETA = 10000.0
N_GROUPS = 4
EXPERTS_PER_GROUP = 8
N_EXPERTS = N_GROUPS * EXPERTS_PER_GROUP
EXPERT_FF = 256
TOP_K_IN_GROUP = 2
LN_EPS = 1e-5
RMS_EPS = 1e-6
DEEPNORM_ALPHA = (2 * DEPTH) ** 0.25
DEEPNORM_BETA = (8 * DEPTH) ** -0.25

A_Q_COLS = A_HEADS * A_HEAD_DIM
A_KV_COLS = A_KV_HEADS * A_HEAD_DIM
A_WIDTH = A_HEADS * A_HEAD_DIM
B_WIDTH = B_HEADS * B_V_DIM
MIX_WIDTH = A_WIDTH + B_WIDTH
IN_SPLITS = (A_Q_COLS,
             A_Q_COLS + A_KV_COLS,
             A_Q_COLS + 2 * A_KV_COLS,
             A_Q_COLS + 2 * A_KV_COLS + B_Q_RANK,
             A_Q_COLS + 2 * A_KV_COLS + B_Q_RANK + B_KV_RANK)
IN_COLS = A_Q_COLS + 2 * A_KV_COLS + B_Q_RANK + B_KV_RANK + B_ROPE_DIM
NEG_BIG = -1e30

kernel_name = "hybrid_swa_mla_hiermoe_deepnorm"


def layer_norm(x, g, b):
    xf = x.astype(jnp.float32)
    mu = jnp.mean(xf, -1, keepdims=True)
    xc = xf - mu
    var = jnp.mean(xc * xc, -1, keepdims=True)
    return (xc * lax.rsqrt(var + LN_EPS) * g.astype(jnp.float32) + b.astype(jnp.float32)).astype(x.dtype)


def rms_norm(x, g):
    xf = x.astype(jnp.float32)
    return (xf * lax.rsqrt(jnp.mean(xf * xf, -1, keepdims=True) + RMS_EPS) * g.astype(jnp.float32)).astype(x.dtype)


def rope_cos_sin(positions, dim):
    inv = 1.0 / (ROPE_THETA ** (jnp.arange(0, dim, 2, dtype=jnp.float32) / dim))
    ang = positions.astype(jnp.float32)[..., None] * inv
    return jnp.cos(ang), jnp.sin(ang)


def apply_rope(x, cos, sin):
    x1, x2 = jnp.split(x.astype(jnp.float32), 2, axis=-1)
    c = cos[:, :, None, :]
    s = sin[:, :, None, :]
    return jnp.concatenate([x1 * c - x2 * s, x1 * s + x2 * c], axis=-1).astype(x.dtype)


def windowed_gqa_sink(q, k, v, sink):
    b, s, h, d = q.shape
    kvh = k.shape[2]
    g = h // kvh
    nb = s // BLOCK
    qb = q.reshape(b, nb, BLOCK, kvh, g, d)

    def bands(t):
        tp = jnp.pad(t, ((0, 0), (BLOCK, BLOCK), (0, 0), (0, 0))).reshape(b, nb + 2, BLOCK, kvh, d)
        return jnp.concatenate([tp[:, :-2], tp[:, 1:-1], tp[:, 2:]], axis=2)

    kb = bands(k)
    vb = bands(v)
    scores = jnp.einsum('bnqkgd,bnskd->bnkgqs', qb, kb,
                        preferred_element_type=jnp.float32) * (d ** -0.5)
    qpos = jnp.arange(nb)[:, None] * BLOCK + jnp.arange(BLOCK)[None, :]
    kpos = jnp.arange(nb)[:, None] * BLOCK - BLOCK + jnp.arange(3 * BLOCK)[None, :]
    kp = kpos[:, None, :]
    valid = (kp >= 0) & (kp < s) & (jnp.abs(kp - qpos[:, :, None]) <= WINDOW)
    scores = jnp.where(valid[None, :, None, None], scores, NEG_BIG)
    sk = sink.astype(jnp.float32).reshape(1, 1, kvh, g, 1, 1)
    m = jnp.maximum(jnp.max(scores, -1, keepdims=True), sk)
    p = jnp.exp(scores - m)
    p = p / (jnp.sum(p, -1, keepdims=True) + jnp.exp(sk - m))
    out = jnp.einsum('bnkgqs,bnskd->bnqkgd', p.astype(v.dtype), vb)
    return out.reshape(b, s, h * d)


def mla_attention(q_nope, q_rope, k_nope, k_rope, v):
    b, s, h, dn = q_nope.shape
    dv = v.shape[-1]
    nb = s // BLOCK
    scale = (B_NOPE_DIM + B_ROPE_DIM) ** -0.5
    qn_blocks = q_nope.reshape(b, nb, BLOCK, h, dn).transpose(1, 0, 2, 3, 4)
    qr_blocks = q_rope.reshape(b, nb, BLOCK, h, q_rope.shape[-1]).transpose(1, 0, 2, 3, 4)

    def one_block(args):
        qn, qr = args
        sc = (jnp.einsum('bqhd,bshd->bhqs', qn, k_nope, preferred_element_type=jnp.float32)
              + jnp.einsum('bqhr,bsr->bhqs', qr, k_rope, preferred_element_type=jnp.float32)) * scale
        p = jax.nn.softmax(sc, axis=-1)
        return jnp.einsum('bhqs,bshd->bqhd', p.astype(v.dtype), v)

    out = lax.map(one_block, (qn_blocks, qr_blocks))
    return out.transpose(1, 0, 2, 3, 4).reshape(b, s, h * dv)


def hierarchical_moe(x, w_group, b_group, w_expert, b_expert, w_gate, w_up, w_down):
    b, s, d = x.shape
    t = x.reshape(b * s, d)
    gl = (t @ w_group).astype(jnp.float32) + b_group.astype(jnp.float32)
    pg = jax.nn.softmax(gl, axis=-1)
    _, g_idx = lax.top_k(gl, 1)
    p_group = jnp.take_along_axis(pg, g_idx, axis=-1)
    el = ((t @ w_expert).astype(jnp.float32) + b_expert.astype(jnp.float32)).reshape(-1, N_GROUPS, EXPERTS_PER_GROUP)
    el_sel = jnp.take_along_axis(el, g_idx[:, :, None], axis=1)[:, 0]
    top_v, top_i = lax.top_k(el_sel, TOP_K_IN_GROUP)
    w = p_group * jax.nn.softmax(top_v, axis=-1)
    e_idx = g_idx * EXPERTS_PER_GROUP + top_i
    combine = jnp.sum(jax.nn.one_hot(e_idx, N_EXPERTS, dtype=jnp.float32) * w[..., None], axis=1)
    y = jnp.zeros(t.shape, jnp.float32)
    for e in range(N_EXPERTS):
        hid = jax.nn.silu(t @ w_gate[e]) * (t @ w_up[e])
        y = y + combine[:, e:e + 1] * (hid @ w_down[e]).astype(jnp.float32)
    return y.astype(x.dtype).reshape(b, s, d)


def setup_inputs(seed: int = 0) -> dict:
    key = jax.random.key(seed)
    ks = jax.random.split(key, 26)
    L, D = DEPTH, D_MODEL
    f32 = jnp.float32

    def nrm(k, shape, scale):
        return jax.random.normal(k, shape, f32) * scale

    offs = jax.random.randint(ks[1], (BATCH, 1), 0, 4096, dtype=jnp.int32)
    positions = jnp.arange(SEQ, dtype=jnp.int32)[None, :] + offs
    return {
        "x": nrm(ks[0], (BATCH, SEQ, D), 1.0),
        "positions": positions,
        "ln_emb_g": 1.0 + nrm(ks[2], (D,), 0.02),
        "ln_emb_b": nrm(ks[3], (D,), 0.02),
        "w_in": nrm(ks[4], (L, D, IN_COLS), D ** -0.5),
        "a_sink": nrm(ks[5], (L, A_HEADS), 1.0),
        "q_a_norm_g": 1.0 + nrm(ks[6], (L, B_Q_RANK), 0.02),
        "w_q_b": nrm(ks[7], (L, B_Q_RANK, B_HEADS * (B_NOPE_DIM + B_ROPE_DIM)), B_Q_RANK ** -0.5),
        "kv_a_norm_g": 1.0 + nrm(ks[8], (L, B_KV_RANK), 0.02),
        "w_kv_b": nrm(ks[9], (L, B_KV_RANK, B_HEADS * (B_NOPE_DIM + B_V_DIM)), B_KV_RANK ** -0.5),
        "out_norm_a_g": 1.0 + nrm(ks[10], (L, A_WIDTH), 0.02),
        "out_norm_b_g": 1.0 + nrm(ks[11], (L, B_WIDTH), 0.02),
        "w_out": nrm(ks[12], (L, MIX_WIDTH, D), MIX_WIDTH ** -0.5 * DEEPNORM_BETA),
        "ln_attn_g": 1.0 + nrm(ks[13], (L, D), 0.02),
        "ln_attn_b": nrm(ks[14], (L, D), 0.02),
        "w_group": nrm(ks[15], (L, D, N_GROUPS), D ** -0.5),
        "b_group": nrm(ks[16], (L, N_GROUPS), 0.01),
        "w_expert": nrm(ks[17], (L, D, N_EXPERTS), D ** -0.5),
        "b_expert": nrm(ks[18], (L, N_EXPERTS), 0.01),
        "w_gate": nrm(ks[19], (L, N_EXPERTS, D, EXPERT_FF), D ** -0.5),
        "w_up": nrm(ks[20], (L, N_EXPERTS, D, EXPERT_FF), D ** -0.5),
        "w_down": nrm(ks[21], (L, N_EXPERTS, EXPERT_FF, D), EXPERT_FF ** -0.5 * DEEPNORM_BETA),
        "ln_ffn_g": 1.0 + nrm(ks[22], (L, D), 0.02),
        "ln_ffn_b": nrm(ks[23], (L, D), 0.02),
    }


def reference(x, positions, ln_emb_g, ln_emb_b, w_in, a_sink, q_a_norm_g, w_q_b, kv_a_norm_g, w_kv_b,
              out_norm_a_g, out_norm_b_g, w_out, ln_attn_g, ln_attn_b, w_group, b_group, w_expert,
              b_expert, w_gate, w_up, w_down, ln_ffn_g, ln_ffn_b):
    b, s, _ = x.shape
    h = layer_norm(x, ln_emb_g, ln_emb_b)
    cos_a, sin_a = rope_cos_sin(positions, A_HEAD_DIM)
    cos_b, sin_b = rope_cos_sin(positions, B_ROPE_DIM)
    for l in range(DEPTH):
        proj = h @ w_in[l]
        qa, ka, va, cq, ckv, kr = jnp.split(proj, IN_SPLITS, axis=-1)
        qa = apply_rope(qa.reshape(b, s, A_HEADS, A_HEAD_DIM), cos_a, sin_a)
        ka = apply_rope(ka.reshape(b, s, A_KV_HEADS, A_HEAD_DIM), cos_a, sin_a)
        va = va.reshape(b, s, A_KV_HEADS, A_HEAD_DIM)
        out_a = windowed_gqa_sink(qa, ka, va, a_sink[l])
        qb = (rms_norm(cq, q_a_norm_g[l]) @ w_q_b[l]).reshape(b, s, B_HEADS, B_NOPE_DIM + B_ROPE_DIM)
        q_nope = qb[..., :B_NOPE_DIM]
        q_rope = apply_rope(qb[..., B_NOPE_DIM:], cos_b, sin_b)
        kv = (rms_norm(ckv, kv_a_norm_g[l]) @ w_kv_b[l]).reshape(b, s, B_HEADS, B_NOPE_DIM + B_V_DIM)
        k_nope = kv[..., :B_NOPE_DIM]
        v_b = kv[..., B_NOPE_DIM:]
        k_rope = apply_rope(kr[:, :, None, :], cos_b, sin_b)[:, :, 0]
        out_b = mla_attention(q_nope, q_rope, k_nope, k_rope, v_b)
        mixed = jnp.concatenate([rms_norm(out_a, out_norm_a_g[l]), rms_norm(out_b, out_norm_b_g[l])], axis=-1) @ w_out[l]
        h = layer_norm(DEEPNORM_ALPHA * h + mixed, ln_attn_g[l], ln_attn_b[l])
        ffn = hierarchical_moe(h, w_group[l], b_group[l], w_expert[l], b_expert[l], w_gate[l], w_up[l], w_down[l])
        h = layer_norm(DEEPNORM_ALPHA * h + ffn, ln_ffn_g[l], ln_ffn_b[l])
    return h
```

```cpp
#include <hip/hip_runtime.h>
#include <cstdio>
#include <cstdint>

#ifndef MK_N_LAUNCHES
#define MK_N_LAUNCHES 1
#endif
constexpr int N_PHASES = 9;
constexpr int N_LAUNCHES = MK_N_LAUNCHES;

#define LAS __attribute__((address_space(3)))
#define GAS __attribute__((address_space(1)))
typedef unsigned short bf16_t;
typedef short bf16x8 __attribute__((ext_vector_type(8)));
typedef float f32x4 __attribute__((ext_vector_type(4)));
typedef float f32x16 __attribute__((ext_vector_type(16)));
typedef unsigned u32x4 __attribute__((ext_vector_type(4)));
typedef unsigned u32x2 __attribute__((ext_vector_type(2)));

constexpr int NB = 2, S = 16384, T = NB * S, D = 1024;
constexpr int IN_COLS = 1824, N1 = 2048;
constexpr int NEXP = 32, EFF = 256;
constexpr float LN_EPS = 1e-5f, RMS_EPS = 1e-6f;
constexpr float DN_ALPHA = 1.189207115002721f;
constexpr float LOG2E = 1.4426950408889634f;
constexpr float SC_A = 0.125f * LOG2E;
constexpr float Q8_PRE = 2.0f, K8_PRE = 0.5f;
constexpr float SC_B = 0.10206207261596575f * LOG2E;

constexpr size_t MiB = 1u << 20;
constexpr size_t WS_CTL = 0, CTL_ZERO_BYTES = 1 * MiB;
constexpr size_t WS_XSTAT = 1 * MiB;
constexpr size_t WS_WRT = 1 * MiB + 512 * 1024;
constexpr size_t WS_COSA = 2 * MiB, WS_SINA = 6 * MiB, WS_COSB = 10 * MiB, WS_SINB = 12 * MiB;
constexpr size_t WS_W1T = 14 * MiB, WS_W2Q = 18 * MiB, WS_W2KV = 20 * MiB, WS_W4T = 21 * MiB, WS_WGU = 23 * MiB, WS_WD = 55 * MiB;
constexpr size_t WS_LTOK = 71 * MiB, WS_LW = 75 * MiB;
constexpr size_t WS_H0B = 80 * MiB;
constexpr size_t WS_CQ = 144 * MiB;
constexpr size_t WS_CKV = 192 * MiB;
constexpr size_t WS_QA = 208 * MiB, WS_KA = 240 * MiB, WS_VAT = 248 * MiB, WS_KR = 256 * MiB;
constexpr size_t WS_QB = 260 * MiB, WS_KN = 308 * MiB, WS_VBT = 340 * MiB;
constexpr size_t WS_H1PRE = 372 * MiB;
constexpr size_t WS_Y = 208 * MiB;
constexpr size_t WS_END = 500 * MiB;
constexpr int CW_BAR = 4096;
constexpr int CW_ECNT = 8192;
constexpr int CW_KN2 = 10240, CW_KR2 = 10240 + 64;
constexpr int CW_SSQ_Q = 65536, CW_SSQ_KV = CW_SSQ_Q + T, CW_SSQ_A = CW_SSQ_KV + T, CW_SSQ_B = CW_SSQ_A + T, CW_S1 = CW_SSQ_B + T, CW_S2 = CW_S1 + T;
static_assert((size_t)(CW_S2 + T) * 4 <= CTL_ZERO_BYTES, "ctl");

constexpr int RING_BYTES = 135168;
constexpr int MISC_OFF = RING_BYTES;
constexpr int LDS_BYTES = 147456;
constexpr int NWAVES = 8;

#define RLX_AGENT __ATOMIC_RELAXED, __HIP_MEMORY_SCOPE_AGENT
typedef float f32x2_t __attribute__((ext_vector_type(2))); typedef __bf16 bf16x2_t __attribute__((ext_vector_type(2)));
__device__ __forceinline__ unsigned cvt_pk_bf16(float lo, float hi) { const f32x2_t v = {lo, hi}; const bf16x2_t b = __builtin_convertvector(v, bf16x2_t); return __builtin_bit_cast(unsigned, b); }
__device__ __forceinline__ float bf_lo(unsigned w) { return __uint_as_float(w << 16); }
__device__ __forceinline__ float bf_hi(unsigned w) { return __uint_as_float(w & 0xffff0000u); }
__device__ __forceinline__ float wave_sum(float v) {
#pragma unroll
    for (int o = 1; o < 64; o <<= 1) v += __shfl_xor(v, o);
    return v;
}
__device__ __forceinline__ float fast_rsqrt(float x) { return 1.0f / sqrtf(x); }
__device__ __forceinline__ void wave_amax_nonneg(unsigned* p, float v, int lane) {
#pragma unroll
    for (int o = 1; o < 64; o <<= 1) v = fmaxf(v, __shfl_xor(v, o));
    if (lane == 0) atomicMax(p, __float_as_uint(v));
}
__device__ __forceinline__ int opaque(int v) { asm volatile("" : "+v"(v)); return v; }

#define XB_TMO      128
#define XB_XCNT(j)  (256  + 64 * (j))
#define XB_XSUB(j)  (1280 + 64 * (j))
#define XB_XGEN(j)  (2304 + 64 * (j))
#define XB_TOP      3328
#define XB_TOPGEN   3392
#define XCD_BAR_WORDS 3456
#define XB_SPIN_CAP (1u << 20)
__device__ __forceinline__ unsigned xb_ld(unsigned* p)              { return __hip_atomic_load(p, __ATOMIC_RELAXED, __HIP_MEMORY_SCOPE_AGENT); }
__device__ __forceinline__ unsigned xb_add(unsigned* p, unsigned v) { return __hip_atomic_fetch_add(p, v, __ATOMIC_RELAXED, __HIP_MEMORY_SCOPE_AGENT); }
__device__ __forceinline__ unsigned xb_xcc_id() { return (unsigned)__builtin_amdgcn_s_getreg((3 << 11) | 20) & 0xFu; }
#define XB_SPIN(cond, bar) do { unsigned _sp = 0; while (cond) { __builtin_amdgcn_s_sleep(1); \
    if ((++_sp & 255u) == 0u) { if (xb_ld(&(bar)[XB_TMO])) break; if (_sp > XB_SPIN_CAP) { atomicAdd(&(bar)[XB_TMO], 1u); break; } } } } while (0)
struct XcdBarrier { unsigned* bar; unsigned x; volatile LAS unsigned* st; };
__device__ __forceinline__ XcdBarrier xcd_barrier_post(unsigned* bar, volatile LAS unsigned* st) {
    XcdBarrier b; b.bar = bar; b.x = xb_xcc_id(); b.st = st;
    if (threadIdx.x == 0) (void)xb_add(&bar[XB_XCNT(b.x)], 1u);
    return b;
}
__device__ __forceinline__ void xcd_barrier_complete(unsigned* bar, unsigned x, unsigned& nloc, unsigned& nx) {
    const unsigned G = gridDim.x * gridDim.y * gridDim.z;
    unsigned sum, cnt, mine, sp = 0u;
    for (;;) {
        sum = 0u; cnt = 0u; mine = 0u;
#pragma unroll
        for (unsigned j = 0; j < 16; ++j) { const unsigned c = xb_ld(&bar[XB_XCNT(j)]); sum += c; cnt += (c > 0u) ? 1u : 0u; mine = (j == x) ? c : mine; }
        if (sum == G) break;
        __builtin_amdgcn_s_sleep(1);
        if ((++sp & 255u) == 0u) { if (xb_ld(&bar[XB_TMO])) break; if (sp > XB_SPIN_CAP) { atomicAdd(&bar[XB_TMO], 1u); break; } }
    }
    nloc = mine > 0u ? mine : 1u; nx = cnt > 0u ? cnt : 1u;
}
__device__ __forceinline__ void xcd_barrier(const XcdBarrier& b) {
    asm volatile("s_waitcnt vmcnt(0)" ::: "memory");
    __syncthreads();
    if (threadIdx.x == 0) {
        unsigned* bar = b.bar;
        __builtin_amdgcn_s_waitcnt(0);
        unsigned nloc = b.st[0], nx = b.st[1];
        if (nloc == 0u) { xcd_barrier_complete(bar, b.x, nloc, nx); b.st[0] = nloc; b.st[1] = nx; }
        const unsigned old = xb_add(&bar[XB_XSUB(b.x)], 1u);
        const unsigned gen = old / nloc;
        if (old + 1u == (gen + 1u) * nloc) {
            __builtin_amdgcn_fence(__ATOMIC_RELEASE, "agent");
            asm volatile("s_waitcnt vmcnt(0)" ::: "memory");
            const unsigned og = xb_add(&bar[XB_TOP], 1u);
            const unsigned tg = og / nx;
            if (og + 1u == (tg + 1u) * nx) xb_add(&bar[XB_TOPGEN], 1u);
            else XB_SPIN(xb_ld(&bar[XB_TOPGEN]) == tg, bar);
            __builtin_amdgcn_fence(__ATOMIC_ACQUIRE, "agent");
            xb_add(&bar[XB_XGEN(b.x)], 1u);
            asm volatile("s_waitcnt vmcnt(0)" ::: "memory");
        } else {
            XB_SPIN(xb_ld(&bar[XB_XGEN(b.x)]) == gen, bar);
            __builtin_amdgcn_fence(__ATOMIC_ACQUIRE, "agent");
            asm volatile("s_waitcnt vmcnt(0)" ::: "memory");
        }
    }
    __syncthreads();
}

namespace pg8 {
constexpr int BM = 256, BK = 64, HALF = 128, HTB = HALF * BK * 2, STAGE_BYTES = 8 * HTB, NXCD = 8, WGM = 8;
__device__ __forceinline__ int lds_byte(int r, int c) { const int st = (r >> 4) * 2 + (c >> 5), rr = r & 15, cc = c & 31, ob = rr * 64 + cc * 2; return st * 1024 + (ob ^ (((ob >> 9) & 1) << 5)); }
__device__ __forceinline__ void stage_rc(int b, int& R, int& C) { const int st = b / 1024, sb = b % 1024, swz = sb ^ (((sb >> 9) & 1) << 5); R = (st >> 1) * 16 + swz / 64; C = (st & 1) * 32 + (swz % 64) / 2; }
__device__ __forceinline__ int perm32(int rho) { const int n = rho >> 4, i = rho & 15; return 8 * (i >> 2) + 4 * n + (i & 3); }

struct Unit { int pm, pn, e, chunk, cnt; };

template <int K> struct DenseSched {
    static constexpr bool GATHER = false;
    const bf16_t* A; const bf16_t* Bt; int nM, nN, nwg, G, c;
    __device__ void init(const bf16_t* A_, const bf16_t* Bt_, int M, int N, int G_, int c_) { A = A_; Bt = Bt_; nM = M / BM; nN = N / BM; nwg = nM * nN; G = G_; c = c_; }
    __device__ bool next(int i, Unit& u) const {
        const long L = (long)i * G + c; if (L >= nwg) return false;
        int wgid = (int)L; { const int q = nwg / NXCD, r = nwg % NXCD, xcd = wgid % NXCD, off = wgid / NXCD; wgid = (xcd < r ? xcd * (q + 1) : r * (q + 1) + (xcd - r) * q) + off; }
        const int nig = WGM * nN, gid = wgid / nig, fm = gid * WGM, gsz = (nM - fm) < WGM ? (nM - fm) : WGM;
        u.pm = fm + ((wgid % nig) % gsz); u.pn = (wgid % nig) / gsz; u.e = 0; u.chunk = 0; u.cnt = 0; return true;
    }
    __device__ __forceinline__ const char* a_base(const Unit& u) const { return (const char*)A + (size_t)u.pm * BM * K * 2; }
    __device__ __forceinline__ const char* b_base(const Unit& u) const { return (const char*)Bt + (size_t)u.pn * BM * K * 2; }
    __device__ __forceinline__ void a_offs(const Unit&, const int (&R)[2], const int (&C)[2], unsigned (&v0)[2], unsigned (&v1)[2]) const {
#pragma unroll
        for (int i = 0; i < 2; ++i) { v0[i] = (unsigned)(R[i] * K + C[i]) * 2u; v1[i] = v0[i] + (unsigned)(HALF * K) * 2u; }
    }
};

template <class Epi, class Sched, bool ALIGN_EPI, int K>
__device__ __forceinline__ void gemm_phase(LAS unsigned char* lds, const Sched& S, const Epi& E) {
    const int tid = threadIdx.x, wid = __builtin_amdgcn_readfirstlane(tid >> 6), lane = tid & 63, wr = wid >> 2, wc = wid & 3, fr = lane & 15, fq = lane >> 4;
    constexpr int nt = K / BK;
    unsigned voffB[2]; int Rs[2], Cs[2];
#pragma unroll
    for (int i = 0; i < 2; ++i) { int R, C; stage_rc(tid * 16 + i * 8192, R, C); Rs[i] = R; Cs[i] = C; const int Rb = Epi::PERM ? ((R & ~31) + perm32(R & 31)) : R;
        voffB[i] = (unsigned)(Rb * K + C) * 2u; }
    const size_t kstep = (size_t)(BK * 2);
    const size_t hstepB = (size_t)HALF * K * 2;
    const unsigned ldsw = (unsigned)wid * 1024u;
    const int aoff = lds_byte(wr * 64 + fr, fq * 8), boff = lds_byte(wc * 32 + fr, fq * 8);
#define PG8_SA(b, h) (((b) * 2 + (h)) * HTB)
#define PG8_SB(b, h) ((4 + (b) * 2 + (h)) * HTB)
#define PG8_STAGE(bufoff, gbase, voff) do { _Pragma("unroll") for (int _i = 0; _i < 2; ++_i) \
        __builtin_amdgcn_global_load_lds((const unsigned*)((const char*)(gbase) + (voff)[_i]), (LAS unsigned*)(lds + (bufoff) + ldsw + _i * 8192), 16, 0, 0); } while (0)
#define PG8_LDA(dst, b, h) do { _Pragma("unroll") for (int m = 0; m < 4; ++m) _Pragma("unroll") for (int k = 0; k < 2; ++k) dst[m][k] = *(const LAS bf16x8*)(lds + PG8_SA(b, h) + aoff + m * 2048 + k * 1024); } while (0)
#define PG8_LDB(dst, b, h) do { _Pragma("unroll") for (int n = 0; n < 2; ++n) _Pragma("unroll") for (int k = 0; k < 2; ++k) dst[n][k] = *(const LAS bf16x8*)(lds + PG8_SB(b, h) + boff + n * 2048 + k * 1024); } while (0)
#define PG8_MMA(ai, bj, At, Bt) do { __builtin_amdgcn_s_setprio(1); _Pragma("unroll") for (int m = 0; m < 4; ++m) _Pragma("unroll") for (int n = 0; n < 2; ++n) _Pragma("unroll") for (int k = 0; k < 2; ++k) \
        acc[ai][bj][m][n] = __builtin_amdgcn_mfma_f32_16x16x32_bf16(Bt[n][k], At[m][k], acc[ai][bj][m][n], 0, 0, 0); __builtin_amdgcn_s_setprio(0); } while (0)
#define PG8_WAIT_V(n) asm volatile("s_waitcnt vmcnt(" #n ")" ::: "memory")
#define PG8_WAIT_L(n) asm volatile("s_waitcnt lgkmcnt(" #n ")" ::: "memory")
#define PG8_BAR __builtin_amdgcn_s_barrier()
#define PG8_SCHED __builtin_amdgcn_sched_barrier(0)
    Unit cur, nxt; int ui = 0;
    if (!S.next(0, cur)) return;
    f32x4 acc[2][2][4][2];
#pragma unroll
    for (int a = 0; a < 2; ++a)
#pragma unroll
        for (int b = 0; b < 2; ++b)
#pragma unroll
            for (int m = 0; m < 4; ++m)
#pragma unroll
                for (int n = 0; n < 2; ++n) acc[a][b][m][n] = (f32x4){0.f, 0.f, 0.f, 0.f};
    bf16x8 At[4][2], B0[2][2], B1[2][2];
    unsigned vA0[2], vA1[2], nA0[2], nA1[2];
    S.a_offs(cur, Rs, Cs, vA0, vA1);
    const char* cA = S.a_base(cur); const char* cB = S.b_base(cur);
    PG8_STAGE(PG8_SB(0, 0), cB, voffB); PG8_STAGE(PG8_SB(0, 1), cB + hstepB, voffB); PG8_STAGE(PG8_SA(0, 0), cA, vA0); PG8_STAGE(PG8_SA(0, 1), cA, vA1);
    if (wr == 1) PG8_BAR;
    PG8_WAIT_V(2); PG8_BAR;
    PG8_STAGE(PG8_SB(1, 0), cB + kstep, voffB); PG8_STAGE(PG8_SA(1, 0), cA + kstep, vA0); PG8_STAGE(PG8_SB(1, 1), cB + hstepB + kstep, voffB);
    PG8_WAIT_V(6); PG8_BAR;
    for (;;) {
        const bool has_next = S.next(ui + 1, nxt);
        const char* nA = has_next ? S.a_base(nxt) : cA; const char* nB = has_next ? S.b_base(nxt) : cB;
        if constexpr (Sched::GATHER) {
            if (has_next) S.a_offs(nxt, Rs, Cs, nA0, nA1);
            else {
#pragma unroll
                for (int i = 0; i < 2; ++i) { nA0[i] = vA0[i]; nA1[i] = vA1[i]; }
            }
        }
#pragma nounroll
        for (int t = 0; t < nt; t += 2) {
            const bool last = (t == nt - 2);
            if constexpr (Epi::MIDK) { if (t == nt / 2) E.mid(acc, cur, wr, wc, fr, fq); }
            const char* a1 = cA + (size_t)(t + 1) * kstep;
            const char* a2 = last ? nA : cA + (size_t)(t + 2) * kstep; const char* b2 = last ? nB : cB + (size_t)(t + 2) * kstep;
            const char* a3 = a2 + kstep; const char* b3 = b2 + kstep;
            unsigned s0[2], s1[2];
            if constexpr (Sched::GATHER) {
#pragma unroll
                for (int i = 0; i < 2; ++i) { s0[i] = last ? nA0[i] : vA0[i]; s1[i] = last ? nA1[i] : vA1[i]; }
            } else {
#pragma unroll
                for (int i = 0; i < 2; ++i) { s0[i] = vA0[i]; s1[i] = vA1[i]; }
            }
            PG8_LDB(B0, 0, 0); PG8_LDB(B1, 0, 1); PG8_SCHED; PG8_LDA(At, 0, 0); PG8_STAGE(PG8_SA(1, 1), a1, vA1);
            PG8_WAIT_V(8); PG8_WAIT_L(0); PG8_BAR; PG8_MMA(0, 0, At, B0); PG8_MMA(0, 1, At, B1); PG8_BAR; PG8_SCHED;
            PG8_LDA(At, 0, 1); PG8_STAGE(PG8_SB(0, 0), b2, voffB); PG8_STAGE(PG8_SB(0, 1), b2 + hstepB, voffB); PG8_STAGE(PG8_SA(0, 0), a2, s0);
            PG8_WAIT_V(8); PG8_WAIT_L(0); PG8_BAR; PG8_MMA(1, 0, At, B0); PG8_MMA(1, 1, At, B1); PG8_BAR; PG8_SCHED;
            PG8_LDB(B0, 1, 0); PG8_LDB(B1, 1, 1); PG8_SCHED; PG8_LDA(At, 1, 0); PG8_STAGE(PG8_SA(0, 1), a2, s1);
            PG8_WAIT_V(8); PG8_WAIT_L(0); PG8_BAR; PG8_MMA(0, 0, At, B0); PG8_MMA(0, 1, At, B1); PG8_BAR; PG8_SCHED;
            PG8_LDA(At, 1, 1); PG8_STAGE(PG8_SB(1, 0), b3, voffB); PG8_STAGE(PG8_SB(1, 1), b3 + hstepB, voffB); PG8_STAGE(PG8_SA(1, 0), a3, s0);
            PG8_WAIT_V(8); PG8_WAIT_L(0); PG8_BAR; PG8_MMA(1, 0, At, B0); PG8_MMA(1, 1, At, B1); PG8_BAR; PG8_SCHED;
        }
        if constexpr (ALIGN_EPI) { if (wr == 0) PG8_BAR; }
        E(acc, cur, wr, wc, fr, fq);
        if (!has_next) break;
#pragma unroll
        for (int a = 0; a < 2; ++a)
#pragma unroll
            for (int b = 0; b < 2; ++b)
#pragma unroll
                for (int m = 0; m < 4; ++m)
#pragma unroll
                    for (int n = 0; n < 2; ++n) acc[a][b][m][n] = (f32x4){0.f, 0.f, 0.f, 0.f};
        cur = nxt; cA = nA; cB = nB; ++ui;
        if constexpr (Sched::GATHER) {
#pragma unroll
            for (int i = 0; i < 2; ++i) { vA0[i] = nA0[i]; vA1[i] = nA1[i]; }
        }
        if constexpr (ALIGN_EPI) { if (wr == 1) PG8_BAR; }
    }
    PG8_WAIT_V(0);
    if constexpr (!ALIGN_EPI) { if (wr == 0) PG8_BAR; }
    PG8_BAR;
#undef PG8_SA
#undef PG8_SB
#undef PG8_STAGE
#undef PG8_LDA
#undef PG8_LDB
#undef PG8_MMA
#undef PG8_WAIT_V
#undef PG8_WAIT_L
#undef PG8_BAR
#undef PG8_SCHED
}
}
using pg8::Unit;

__device__ __forceinline__ void rope4(const f32x4 x1, const f32x4 x2, const f32x4 c, const f32x4 s, float sc, u32x4& w) {
    const f32x4 o1 = (x1 * c - x2 * s) * sc, o2 = (x1 * s + x2 * c) * sc;
    w.x = cvt_pk_bf16(o1[0], o1[1]); w.y = cvt_pk_bf16(o1[2], o1[3]); w.z = cvt_pk_bf16(o2[0], o2[1]); w.w = cvt_pk_bf16(o2[2], o2[3]);
}
__device__ __forceinline__ u32x4 pack8(const f32x4 a, const f32x4 b, float sc) {
    u32x4 w; w.x = cvt_pk_bf16(a[0] * sc, a[1] * sc); w.y = cvt_pk_bf16(a[2] * sc, a[3] * sc); w.z = cvt_pk_bf16(b[0] * sc, b[1] * sc); w.w = cvt_pk_bf16(b[2] * sc, b[3] * sc); return w;
}
__device__ __forceinline__ u32x2 pack8_fp8(const f32x4 a, const f32x4 b, float sc) {
    int w0 = __builtin_amdgcn_cvt_pk_fp8_f32(a[0] * sc, a[1] * sc, 0, false); w0 = __builtin_amdgcn_cvt_pk_fp8_f32(a[2] * sc, a[3] * sc, w0, true);
    int w1 = __builtin_amdgcn_cvt_pk_fp8_f32(b[0] * sc, b[1] * sc, 0, false); w1 = __builtin_amdgcn_cvt_pk_fp8_f32(b[2] * sc, b[3] * sc, w1, true);
    u32x2 w; w.x = (unsigned)w0; w.y = (unsigned)w1; return w;
}
__device__ __forceinline__ float sq4(const f32x4 a) { return (a[0] * a[0] + a[1] * a[1]) + (a[2] * a[2] + a[3] * a[3]); }
__device__ __forceinline__ void store_vt8(bf16_t* base, const f32x4 a, const f32x4 b, float sc) {
    const u32x4 w = pack8(a, b, sc);
    base[0 * 64] = (bf16_t)(w.x & 0xffff); base[1 * 64] = (bf16_t)(w.x >> 16); base[2 * 64] = (bf16_t)(w.y & 0xffff); base[3 * 64] = (bf16_t)(w.y >> 16);
    base[4 * 64] = (bf16_t)(w.z & 0xffff); base[5 * 64] = (bf16_t)(w.z >> 16); base[6 * 64] = (bf16_t)(w.w & 0xffff); base[7 * 64] = (bf16_t)(w.w >> 16);
}

struct Epi1 {
    static constexpr bool PERM = true, MIDK = false;
    bf16_t *Qa, *Ka, *VaT, *cq, *ckv, *Kr; float *ssq_q, *ssq_kv; const float *cosA, *sinA, *cosB, *sinB; unsigned* kr2;
    __device__ __forceinline__ void mid(f32x4 (&)[2][2][4][2], const Unit&, int, int, int, int) const {}
    __device__ __forceinline__ void operator()(const f32x4 (&acc)[2][2][4][2], const Unit& u, int wr, int wc, int fr, int fq) const {
        const int pn = u.pn, row0 = opaque(u.pm * 256 + wr * 64 + fr);
        if (pn < 2) {
#pragma unroll
            for (int ai = 0; ai < 2; ++ai)
#pragma unroll
                for (int m = 0; m < 4; ++m) { const int row = row0 + ai * 128 + m * 16; const int a = (wc & 1) * 4 + fq;
                    const f32x4 c = *(const f32x4*)(cosA + (size_t)row * 32 + 4 * a), s = *(const f32x4*)(sinA + (size_t)row * 32 + 4 * a);
#pragma unroll
                    for (int bj = 0; bj < 2; ++bj) { const int hd = pn * 4 + bj * 2 + (wc >> 1); u32x4 w; rope4(acc[ai][bj][m][0], acc[ai][bj][m][1], c, s, SC_A, w);
                        *(u32x4*)(Qa + (size_t)row * 512 + hd * 64 + 8 * a) = w; } }
        } else if (pn == 2) {
#pragma unroll
            for (int ai = 0; ai < 2; ++ai)
#pragma unroll
                for (int m = 0; m < 4; ++m) { const int row = row0 + ai * 128 + m * 16; const int a = (wc & 1) * 4 + fq, kvh = wc >> 1, b = row / S, s_ = row % S;
                    const f32x4 c = *(const f32x4*)(cosA + (size_t)row * 32 + 4 * a), s = *(const f32x4*)(sinA + (size_t)row * 32 + 4 * a);
                    u32x4 w; rope4(acc[ai][0][m][0], acc[ai][0][m][1], c, s, 1.0f, w);
                    *(u32x4*)(Ka + ((size_t)(b * 2 + kvh) * S + s_) * 64 + 8 * a) = w;
                    store_vt8(VaT + ((size_t)(b * 2 + kvh) * (S / 64) + (s_ >> 6)) * 4096 + (size_t)(8 * a) * 64 + (s_ & 63), acc[ai][1][m][0], acc[ai][1][m][1], 1.0f); }
        } else if (pn < 7) {
            bf16_t* dst = (pn < 6) ? cq : ckv; const int ld = (pn < 6) ? 768 : 256; const int cbase = (pn < 6) ? (pn - 3) * 256 : 0; float* ssq = (pn < 6) ? ssq_q : ssq_kv;
#pragma unroll
            for (int ai = 0; ai < 2; ++ai)
#pragma unroll
                for (int m = 0; m < 4; ++m) { const int row = row0 + ai * 128 + m * 16; float q = 0.f;
#pragma unroll
                    for (int bj = 0; bj < 2; ++bj) { *(u32x4*)(dst + (size_t)row * ld + cbase + bj * 128 + wc * 32 + fq * 8) = pack8(acc[ai][bj][m][0], acc[ai][bj][m][1], 1.0f);
                        q += sq4(acc[ai][bj][m][0]) + sq4(acc[ai][bj][m][1]); }
                    q += __shfl_xor(q, 16); q += __shfl_xor(q, 32);
                    if (fq == 0) atomicAdd(ssq + row, q); }
        } else {
            if (wc == 0) {
                float nmax = 0.f;
#pragma unroll
                for (int ai = 0; ai < 2; ++ai)
#pragma unroll
                    for (int m = 0; m < 4; ++m) { const int row = row0 + ai * 128 + m * 16;
                        const f32x4 c = *(const f32x4*)(cosB + (size_t)row * 16 + 4 * fq), s = *(const f32x4*)(sinB + (size_t)row * 16 + 4 * fq);
                        u32x4 w; rope4(acc[ai][0][m][0], acc[ai][0][m][1], c, s, 1.0f, w);
                        *(u32x4*)(Kr + (size_t)row * 32 + 8 * fq) = w;
                        float q = sq4(acc[ai][0][m][0]) + sq4(acc[ai][0][m][1]);
                        q += __shfl_xor(q, 16); q += __shfl_xor(q, 32); nmax = fmaxf(nmax, q); }
                wave_amax_nonneg(kr2 + (u.pm * 256) / S, nmax, (fq << 4) | fr);
            }
        }
    }
};
struct Epi2q {
    static constexpr bool PERM = true, MIDK = false;
    bf16_t* Qb; unsigned char* Qn8; const float* ssq_q; const float *cosB, *sinB;
    __device__ __forceinline__ void mid(f32x4 (&)[2][2][4][2], const Unit&, int, int, int, int) const {}
    __device__ __forceinline__ void operator()(const f32x4 (&acc)[2][2][4][2], const Unit& u, int wr, int wc, int fr, int fq) const {
        const int pn = u.pn, row0 = opaque(u.pm * 256 + wr * 64 + fr);
#pragma unroll
        for (int ai = 0; ai < 2; ++ai)
#pragma unroll
            for (int m = 0; m < 4; ++m) { const int row = row0 + ai * 128 + m * 16;
                const float rs = fast_rsqrt(ssq_q[row] * (1.0f / 768.0f) + RMS_EPS) * SC_B;
                if (pn < 2) {
#pragma unroll
                    for (int bj = 0; bj < 2; ++bj) { const int hd = pn * 4 + bj * 2 + (wc >> 1), d0 = (wc & 1) * 32 + 8 * fq;
                        *(u32x2*)(Qn8 + (size_t)row * 512 + hd * 64 + d0) = pack8_fp8(acc[ai][bj][m][0], acc[ai][bj][m][1], rs * Q8_PRE); }
                } else {
                    const f32x4 c = *(const f32x4*)(cosB + (size_t)row * 16 + 4 * fq), s = *(const f32x4*)(sinB + (size_t)row * 16 + 4 * fq);
#pragma unroll
                    for (int bj = 0; bj < 2; ++bj) { const int hd = bj * 4 + wc; u32x4 w; rope4(acc[ai][bj][m][0], acc[ai][bj][m][1], c, s, rs, w);
                        *(u32x4*)(Qb + (size_t)row * 768 + hd * 96 + 64 + 8 * fq) = w; }
                }
            }
    }
};
struct Epi2kv {
    static constexpr bool PERM = true, MIDK = false;
    bf16_t *Kn, *VbT; const float* ssq_kv; unsigned* kn2;
    __device__ __forceinline__ void mid(f32x4 (&)[2][2][4][2], const Unit&, int, int, int, int) const {}
    __device__ __forceinline__ void operator()(const f32x4 (&acc)[2][2][4][2], const Unit& u, int wr, int wc, int fr, int fq) const {
        const int pn = u.pn, row0 = opaque(u.pm * 256 + wr * 64 + fr);
        float nmax[2] = {0.f, 0.f};
#pragma unroll
        for (int ai = 0; ai < 2; ++ai)
#pragma unroll
            for (int m = 0; m < 4; ++m) { const int row = row0 + ai * 128 + m * 16, b = row / S, s_ = row % S;
                const float rs = fast_rsqrt(ssq_kv[row] * (1.0f / 256.0f) + RMS_EPS);
#pragma unroll
                for (int bj = 0; bj < 2; ++bj) { const int hd = (pn & 1) * 4 + bj * 2 + (wc >> 1), d0 = (wc & 1) * 32 + 8 * fq;
                    if (pn < 2) { *(u32x2*)((unsigned char*)Kn + ((size_t)(b * 8 + hd) * S + s_) * 64 + d0) = pack8_fp8(acc[ai][bj][m][0], acc[ai][bj][m][1], rs * K8_PRE);
                        float q = (sq4(acc[ai][bj][m][0]) + sq4(acc[ai][bj][m][1])) * rs * rs;
                        q += __shfl_xor(q, 16); q += __shfl_xor(q, 32); nmax[bj] = fmaxf(nmax[bj], q); }
                    else store_vt8(VbT + ((size_t)(b * 8 + hd) * (S / 64) + (s_ >> 6)) * 4096 + (size_t)d0 * 64 + (s_ & 63), acc[ai][bj][m][0], acc[ai][bj][m][1], rs); }
            }
        if (pn < 2) {
#pragma unroll
            for (int bj = 0; bj < 2; ++bj) wave_amax_nonneg(kn2 + ((size_t)((u.pm * 256) / S) * 8 + pn * 4 + bj * 2 + (wc >> 1)) * 2 + (wc & 1), nmax[bj], (fq << 4) | fr);
        }
    }
};
struct Epi4 {
    static constexpr bool PERM = true, MIDK = true;
    const float *x, *xstat, *g0, *b0, *ssq_a, *ssq_b; bf16_t* h1pre; float *s1, *s2;
    __device__ __forceinline__ void mid(f32x4 (&acc)[2][2][4][2], const Unit& u, int wr, int wc, int fr, int fq) const {
        const int row0 = opaque(u.pm * 256 + wr * 64 + fr);
#pragma unroll
        for (int ai = 0; ai < 2; ++ai)
#pragma unroll
            for (int m = 0; m < 4; ++m) { const int row = row0 + ai * 128 + m * 16;
                const float va = ssq_a[row] * (1.0f / 512.0f) + RMS_EPS, vb = ssq_b[row] * (1.0f / 512.0f) + RMS_EPS;
                const float ratio = sqrtf(vb / va);
#pragma unroll
                for (int bj = 0; bj < 2; ++bj)
#pragma unroll
                    for (int n = 0; n < 2; ++n) acc[ai][bj][m][n] *= ratio; }
    }
    __device__ __forceinline__ void operator()(const f32x4 (&acc)[2][2][4][2], const Unit& u, int wr, int wc, int fr, int fq) const {
        const int row0 = opaque(u.pm * 256 + wr * 64 + fr), col0 = u.pn * 256 + wc * 32 + 8 * fq;
#pragma unroll
        for (int ai = 0; ai < 2; ++ai)
#pragma unroll
            for (int m = 0; m < 4; ++m) { const int row = row0 + ai * 128 + m * 16;
                const float rb = fast_rsqrt(ssq_b[row] * (1.0f / 512.0f) + RMS_EPS);
                const float mean = xstat[2 * row], rstd = xstat[2 * row + 1];
                float t1 = 0.f, t2 = 0.f;
#pragma unroll
                for (int bj = 0; bj < 2; ++bj) { f32x4 v[2];
#pragma unroll
                    for (int n = 0; n < 2; ++n) { const int col = col0 + bj * 128 + n * 4;
                        const f32x4 xv = *(const f32x4*)(x + (size_t)row * D + col), g = *(const f32x4*)(g0 + col), b = *(const f32x4*)(b0 + col);
                        const f32x4 h0 = (xv - mean) * rstd * g + b;
                        v[n] = h0 * DN_ALPHA + acc[ai][bj][m][n] * rb;
                        t1 += (v[n][0] + v[n][1]) + (v[n][2] + v[n][3]); t2 += sq4(v[n]); }
                    *(u32x4*)(h1pre + (size_t)row * D + col0 + bj * 128) = pack8(v[0], v[1], 1.0f); }
                t1 += __shfl_xor(t1, 16); t1 += __shfl_xor(t1, 32); t2 += __shfl_xor(t2, 16); t2 += __shfl_xor(t2, 32);
                if (fq == 0) { atomicAdd(s1 + row, t1); atomicAdd(s2 + row, t2); } }
    }
};
struct EpiGU {
    static constexpr bool PERM = true, MIDK = false;
    bf16_t* hid;
    __device__ __forceinline__ void mid(f32x4 (&)[2][2][4][2], const Unit&, int, int, int, int) const {}
    __device__ __forceinline__ void operator()(const f32x4 (&acc)[2][2][4][2], const Unit& u, int wr, int wc, int fr, int fq) const {
        const int row0 = opaque(u.pm * 256 + wr * 64 + fr), col = u.pn * 128 + wc * 32 + fq * 8;
#pragma unroll
        for (int ai = 0; ai < 2; ++ai)
#pragma unroll
            for (int m = 0; m < 4; ++m) { const int row = row0 + ai * 128 + m * 16; f32x4 h[2];
#pragma unroll
                for (int n = 0; n < 2; ++n)
#pragma unroll
                    for (int e = 0; e < 4; ++e) { const float g = acc[ai][0][m][n][e], up = acc[ai][1][m][n][e]; h[n][e] = g * up / (1.0f + __builtin_amdgcn_exp2f(-g * LOG2E)); }
                *(u32x4*)(hid + (size_t)row * EFF + col) = pack8(h[0], h[1], 1.0f); }
    }
};
struct EpiD {
    static constexpr bool PERM = true, MIDK = false;
    const unsigned* ltok; const float* lw; bf16_t* y;
    __device__ __forceinline__ void mid(f32x4 (&)[2][2][4][2], const Unit&, int, int, int, int) const {}
    __device__ __forceinline__ void operator()(const f32x4 (&acc)[2][2][4][2], const Unit& u, int wr, int wc, int fr, int fq) const {
        const int i0 = opaque(wr * 64 + fr), col0 = u.pn * 256 + wc * 32 + fq * 8;
#pragma unroll
        for (int ai = 0; ai < 2; ++ai)
#pragma unroll
            for (int m = 0; m < 4; ++m) { const int li = u.chunk * 256 + i0 + ai * 128 + m * 16;
                if (li < u.cnt) { const unsigned ent = ltok[(size_t)u.e * T + li]; const float w = lw[(size_t)u.e * T + li];
                    bf16_t* dst = y + (size_t)(ent >> 15) * ((size_t)T * D) + (size_t)(ent & 0x7fffu) * D + col0;
#pragma unroll
                    for (int bj = 0; bj < 2; ++bj) *(u32x4*)(dst + bj * 128) = pack8(acc[ai][bj][m][0], acc[ai][bj][m][1], w); } }
    }
};

template <int MODE> struct MoeSched {
    static constexpr bool GATHER = (MODE == 0);
    const LAS int* tab;
    const bf16_t* A; const bf16_t* W; const unsigned* ltok; int G, c, npn;
    __device__ bool next(int i, Unit& u) const {
        const int ntl = tab[32]; const long L = (long)i * G + c; if (L >= (long)ntl * npn) return false;
        const int tau = (int)(L / npn); int e = 0;
        for (int k = 1; k < 32; ++k) e += (tab[k] <= tau) ? 1 : 0;
        u.pm = tau; u.pn = (int)(L % npn); u.e = e; u.chunk = tau - tab[e]; u.cnt = tab[64 + e]; return true;
    }
    __device__ __forceinline__ const char* a_base(const Unit& u) const { return MODE == 0 ? (const char*)A : (const char*)A + (size_t)u.pm * 256 * EFF * 2; }
    __device__ __forceinline__ const char* b_base(const Unit& u) const {
        return MODE == 0 ? (const char*)W + ((size_t)u.e * 512 + (size_t)u.pn * 256) * D * 2 : (const char*)W + ((size_t)u.e * D + (size_t)u.pn * 256) * EFF * 2; }
    __device__ __forceinline__ void a_offs(const Unit& u, const int (&R)[2], const int (&C)[2], unsigned (&v0)[2], unsigned (&v1)[2]) const {
        if constexpr (MODE == 0) {
#pragma unroll
            for (int i = 0; i < 2; ++i) { const int l0 = u.chunk * 256 + R[i], l1 = l0 + 128;
                const unsigned t0 = l0 < u.cnt ? (ltok[(size_t)u.e * T + l0] & 0x7fffu) : 0u, t1 = l1 < u.cnt ? (ltok[(size_t)u.e * T + l1] & 0x7fffu) : 0u;
                v0[i] = (t0 * (unsigned)D + (unsigned)C[i]) * 2u; v1[i] = (t1 * (unsigned)D + (unsigned)C[i]) * 2u; }
        } else {
#pragma unroll
            for (int i = 0; i < 2; ++i) { v0[i] = (unsigned)(R[i] * EFF + C[i]) * 2u; v1[i] = v0[i] + (unsigned)(128 * EFF) * 2u; }
        }
    }
};

#define MF32(a, b, c) __builtin_amdgcn_mfma_f32_32x32x16_bf16(a, b, c, 0, 0, 0)
#define SBAR() __builtin_amdgcn_sched_barrier(0)
#define LDF(p) (*(const LAS bf16x8*)(p))
__device__ __forceinline__ float max3f(float a, float b, float c) { return fmaxf(fmaxf(a, b), c); }
__device__ __forceinline__ float fadd_s(float a, float b) { float r; asm("v_add_f32_e32 %0, %1, %2" : "=v"(r) : "v"(a), "v"(b)); return r; }
__device__ __forceinline__ float xhalf_max(float v) { auto rr = __builtin_amdgcn_permlane32_swap(__float_as_uint(v), __float_as_uint(v), false, false); return fmaxf(__uint_as_float(rr[0]), __uint_as_float(rr[1])); }
constexpr float MLA_THRL = 8.0f;
#define PIN2(a, b) asm volatile("" : "+v"(a), "+v"(b))
struct MlaSrc { const bf16_t *Kn, *Krp, *Vt; };
struct MlaDma { int ko, ro, wv; };
typedef float f32x2 __attribute__((ext_vector_type(2)));
#define M2_MAX_A(SN, TM) do { float a_ = max3f(SN[0], SN[1], SN[2]), b_ = max3f(SN[3], SN[4], SN[5]); a_ = max3f(a_, SN[6], SN[7]); b_ = max3f(b_, SN[8], SN[9]); TM = fmaxf(a_, b_); } while (0)
#define M2_MAX_B(SN, TM) do { float a_ = max3f(SN[10], SN[11], SN[12]); TM = max3f(TM, SN[13], SN[14]); a_ = fmaxf(a_, SN[15]); TM = fmaxf(TM, a_); TM = xhalf_max(TM); } while (0)
#define M4_E(C, j) do { C[4 * (j) + 0] = __builtin_amdgcn_exp2f(C[4 * (j) + 0]); C[4 * (j) + 1] = __builtin_amdgcn_exp2f(C[4 * (j) + 1]); C[4 * (j) + 2] = __builtin_amdgcn_exp2f(C[4 * (j) + 2]); C[4 * (j) + 3] = __builtin_amdgcn_exp2f(C[4 * (j) + 3]); } while (0)
#define M4_F(C, j, S0, S1, W0, W1) do { S0 = fadd_s(S0, C[4 * (j) + 0]); S1 = fadd_s(S1, C[4 * (j) + 1]); S0 = fadd_s(S0, C[4 * (j) + 2]); S1 = fadd_s(S1, C[4 * (j) + 3]); \
    if ((j) < 2) { W0[2 * ((j) & 1)] = cvt_pk_bf16(C[4 * (j) + 0], C[4 * (j) + 1]); W0[2 * ((j) & 1) + 1] = cvt_pk_bf16(C[4 * (j) + 2], C[4 * (j) + 3]); PIN2(W0[2 * ((j) & 1)], W0[2 * ((j) & 1) + 1]); } \
    else { W1[2 * ((j) & 1)] = cvt_pk_bf16(C[4 * (j) + 0], C[4 * (j) + 1]); W1[2 * ((j) & 1) + 1] = cvt_pk_bf16(C[4 * (j) + 2], C[4 * (j) + 3]); PIN2(W1[2 * ((j) & 1)], W1[2 * ((j) & 1) + 1]); } } while (0)
constexpr int AT3_KR = 4096, AT3_VT = 8192, AT3_BUF = 16384;
#define BUF3(k) (lds + (k) * AT3_BUF)
typedef int i32x8 __attribute__((ext_vector_type(8)));
#define MFS(a, b, c) __builtin_amdgcn_mfma_scale_f32_32x32x64_f8f6f4(a, b, c, 0, 0, 0, 127, 0, 127)
#define CAT8(x, y) ((i32x8){(int)(x)[0], (int)(x)[1], (int)(x)[2], (int)(x)[3], (int)(y)[0], (int)(y)[1], (int)(y)[2], (int)(y)[3]})
#define LDU(p) (*(const LAS u32x4*)(p))
__device__ __forceinline__ void mla_dma8(const MlaDma& dm, const MlaSrc& s, LAS unsigned char* buf, int t) {
    __builtin_amdgcn_global_load_lds((const unsigned*)(s.Vt + (size_t)t * 4096 + dm.ko), (LAS unsigned*)(buf + AT3_VT + dm.wv * 1024), 16, 0, 0);
    if (dm.wv < 4) {
        __builtin_amdgcn_global_load_lds((const unsigned*)((const unsigned char*)s.Kn + (size_t)t * 4096 + dm.ro * 2), (LAS unsigned*)(buf + dm.wv * 1024), 16, 0, 0);
        __builtin_amdgcn_global_load_lds((const unsigned*)(s.Krp + (size_t)t * 2048 + dm.ro), (LAS unsigned*)(buf + AT3_KR + dm.wv * 1024), 16, 0, 0);
    }
}
template <bool HAS_NEXT, bool PRELOAD, bool BAR>
__device__ __forceinline__ void mla8_step(f32x16& ca, f32x16& cb, f32x16& na, f32x16& nb, f32x16& oa0, f32x16& oa1, f32x16& ob0, f32x16& ob1,
                                          float& ma, float& mb, float& la, float& lb, const i32x8& qa8, const i32x8& qb8, const bf16x8 (&qar)[2], const bf16x8 (&qbr)[2], u32x4 (&kN)[2], bf16x8 (&kR)[2],
                                          const LAS unsigned char* vbuf, const LAS unsigned char* nkn, const LAS unsigned char* nkr, const int (&kon)[2], const int (&kor)[2], const int (&vo)[2],
                                          const MlaDma& dm, const MlaSrc& dsrc, LAS unsigned char* wbuf, bool do_dma, int tdma, bool track) {
    float sa0 = 0.f, sa1 = 0.f, sb0 = 0.f, sb1 = 0.f; u32x4 pa0, pa1, pb0, pb1; bf16x8 vf[4];
    f32x16 zero16;
#pragma unroll
    for (int r = 0; r < 16; ++r) zero16[r] = 0.f;
    if (HAS_NEXT) {
        const i32x8 k8 = CAT8(kN[0], kN[1]);
        na = MFS(k8, qa8, zero16); SBAR();
        vf[0] = LDF(vbuf + vo[0]); vf[2] = LDF(vbuf + vo[0] + 4096); vf[1] = LDF(vbuf + vo[1]); vf[3] = LDF(vbuf + vo[1] + 4096);
        M4_E(ca, 0); M4_E(ca, 1); SBAR();
        nb = MFS(k8, qb8, zero16); M4_F(ca, 0, sa0, sa1, pa0, pa1); M4_E(ca, 2); SBAR();
        na = MF32(kR[0], qar[0], na); M4_F(ca, 1, sa0, sa1, pa0, pa1); SBAR();
        nb = MF32(kR[0], qbr[0], nb); M4_E(ca, 3); SBAR();
        na = MF32(kR[1], qar[1], na); M4_F(ca, 2, sa0, sa1, pa0, pa1); SBAR();
        nb = MF32(kR[1], qbr[1], nb); M4_F(ca, 3, sa0, sa1, pa0, pa1); SBAR();
    } else {
        vf[0] = LDF(vbuf + vo[0]); vf[2] = LDF(vbuf + vo[0] + 4096); vf[1] = LDF(vbuf + vo[1]); vf[3] = LDF(vbuf + vo[1] + 4096);
        M4_E(ca, 0); M4_E(ca, 1); M4_E(ca, 2); M4_E(ca, 3);
        M4_F(ca, 0, sa0, sa1, pa0, pa1); M4_F(ca, 1, sa0, sa1, pa0, pa1); M4_F(ca, 2, sa0, sa1, pa0, pa1); M4_F(ca, 3, sa0, sa1, pa0, pa1);
    }
    if (BAR) {
        asm volatile("s_waitcnt vmcnt(0)" ::: "memory");
        __syncthreads();
        if (do_dma) mla_dma8(dm, dsrc, wbuf, tdma);
    }
    SBAR();
    const bf16x8 xa0 = __builtin_bit_cast(bf16x8, pa0), xa1 = __builtin_bit_cast(bf16x8, pa1);
    oa0 = MF32(vf[0], xa0, oa0); SBAR();
    if (PRELOAD) { kN[0] = LDU(nkn + kon[0]); kN[1] = LDU(nkn + kon[1]); kR[0] = LDF(nkr + kor[0]); kR[1] = LDF(nkr + kor[1]); }
    M4_E(cb, 0); SBAR();
    oa1 = MF32(vf[2], xa0, oa1); M4_E(cb, 1); M4_F(cb, 0, sb0, sb1, pb0, pb1); SBAR();
    oa0 = MF32(vf[1], xa1, oa0); M4_F(cb, 1, sb0, sb1, pb0, pb1); M4_E(cb, 2); SBAR();
    oa1 = MF32(vf[3], xa1, oa1); M4_E(cb, 3); SBAR();
    const bf16x8 xb0 = __builtin_bit_cast(bf16x8, pb0);
    ob0 = MF32(vf[0], xb0, ob0); M4_F(cb, 2, sb0, sb1, pb0, pb1); SBAR();
    ob1 = MF32(vf[2], xb0, ob1); M4_F(cb, 3, sb0, sb1, pb0, pb1); SBAR();
    const bf16x8 xb1 = __builtin_bit_cast(bf16x8, pb1);
    ob0 = MF32(vf[1], xb1, ob0); SBAR();
    ob1 = MF32(vf[3], xb1, ob1); la += sa0 + sa1; lb += sb0 + sb1; SBAR();
    if (HAS_NEXT && track) {
#pragma unroll
        for (int r = 0; r < 16; ++r) { na[r] -= ma; nb[r] -= mb; }
        float ta, tb; M2_MAX_A(na, ta); M2_MAX_B(na, ta); M2_MAX_A(nb, tb); M2_MAX_B(nb, tb);
        if (__any(ta > MLA_THRL || tb > MLA_THRL)) {
            const float da = fmaxf(ta, 0.f), db_ = fmaxf(tb, 0.f), fa = __builtin_amdgcn_exp2f(-da), fb = __builtin_amdgcn_exp2f(-db_);
            ma += da; mb += db_; la *= fa; lb *= fb;
#pragma unroll
            for (int r = 0; r < 16; ++r) { na[r] -= da; nb[r] -= db_; oa0[r] *= fa; oa1[r] *= fa; ob0[r] *= fb; ob1[r] *= fb; }
        }
    }
}
__device__ __forceinline__ void mla8_unit(LAS unsigned char* lds, const bf16_t* Qu  , const unsigned char* Q8u  , const MlaSrc cs,
                                          float kn_bound, float kr_bound, bf16_t* Ou, float* ssqu) {
    constexpr int NT = S / 64;
    const int tid = opaque((int)threadIdx.x), lane = tid & 63, r32 = lane & 31, hi = lane >> 5, wv = __builtin_amdgcn_readfirstlane(tid >> 6);
    bf16x8 qar[2], qbr[2]; u32x4 qna[2], qnb[2];
#pragma unroll
    for (int g = 0; g < 2; ++g) { qna[g] = *(const u32x4*)(Q8u + (size_t)(64 * wv + r32) * 512 + 32 * hi + 16 * g); qnb[g] = *(const u32x4*)(Q8u + (size_t)(64 * wv + 32 + r32) * 512 + 32 * hi + 16 * g); }
    const i32x8 qa8 = CAT8(qna[0], qna[1]), qb8 = CAT8(qnb[0], qnb[1]);
#pragma unroll
    for (int j = 0; j < 2; ++j) { qar[j] = *(const bf16x8*)(Qu + (size_t)(64 * wv + r32) * 768 + (4 + j) * 16 + hi * 8); qbr[j] = *(const bf16x8*)(Qu + (size_t)(64 * wv + 32 + r32) * 768 + (4 + j) * 16 + hi * 8); }
    MlaDma dm; dm.wv = wv;
    { const int row = 8 * wv + (lane >> 3), lg = (lane & 7) ^ ((row >> 1) & 7); dm.ko = row * 64 + lg * 8;
      const int rr = 16 * wv + (lane >> 2), lr = (lane & 3) ^ ((rr >> 2) & 3); dm.ro = rr * 32 + lr * 8; }
    const int pr = (r32 & ~12) | ((r32 & 4) << 1) | ((r32 & 8) >> 1);
    int kon[2], kor[2], vo0[2], vo1[2];
#pragma unroll
    for (int g = 0; g < 2; ++g) kon[g] = pr * 64 + (((2 * hi + g) ^ ((pr >> 2) & 3)) << 4);
#pragma unroll
    for (int j = 0; j < 2; ++j) kor[j] = AT3_KR + pr * 64 + (((2 * j + hi) ^ ((pr >> 2) & 3)) << 4);
#pragma unroll
    for (int s = 0; s < 2; ++s) { vo0[s] = AT3_VT + r32 * 128 + (((2 * s + hi) ^ ((r32 >> 1) & 7)) << 4); vo1[s] = AT3_VT + r32 * 128 + (((4 + 2 * s + hi) ^ ((r32 >> 1) & 7)) << 4); }
    __syncthreads();
    mla_dma8(dm, cs, lds, 0); mla_dma8(dm, cs, lds + AT3_BUF, 1);
    asm volatile("s_waitcnt vmcnt(0)" ::: "memory");
    __syncthreads();
    bool fast;
    { float an2 = 0.f, ar2 = 0.f, bn2 = 0.f, br2 = 0.f;
#pragma unroll
      for (int g = 0; g < 2; ++g)
#pragma unroll
          for (int e = 0; e < 4; ++e) {
              const int wa = (int)qna[g][e], wb = (int)qnb[g][e];
              const float a0 = __builtin_amdgcn_cvt_f32_fp8(wa, 0), a1 = __builtin_amdgcn_cvt_f32_fp8(wa, 1), a2 = __builtin_amdgcn_cvt_f32_fp8(wa, 2), a3 = __builtin_amdgcn_cvt_f32_fp8(wa, 3);
              const float b0 = __builtin_amdgcn_cvt_f32_fp8(wb, 0), b1 = __builtin_amdgcn_cvt_f32_fp8(wb, 1), b2 = __builtin_amdgcn_cvt_f32_fp8(wb, 2), b3 = __builtin_amdgcn_cvt_f32_fp8(wb, 3);
              an2 += (a0 * a0 + a1 * a1) + (a2 * a2 + a3 * a3); bn2 += (b0 * b0 + b1 * b1) + (b2 * b2 + b3 * b3); }
#pragma unroll
      for (int j = 0; j < 2; ++j) { const u32x4 wa = __builtin_bit_cast(u32x4, qar[j]), wb = __builtin_bit_cast(u32x4, qbr[j]);
#pragma unroll
          for (int e = 0; e < 4; ++e) { const float al = bf_lo(wa[e]), ah = bf_hi(wa[e]), bl = bf_lo(wb[e]), bh = bf_hi(wb[e]); ar2 += al * al + ah * ah; br2 += bl * bl + bh * bh; } }
      an2 += __shfl_xor(an2, 32); ar2 += __shfl_xor(ar2, 32); bn2 += __shfl_xor(bn2, 32); br2 += __shfl_xor(br2, 32);
      const float ba = sqrtf(an2) * (1.15f / Q8_PRE) * kn_bound + sqrtf(ar2) * kr_bound, bb = sqrtf(bn2) * (1.15f / Q8_PRE) * kn_bound + sqrtf(br2) * kr_bound;
      fast = __all(ba < 64.0f && bb < 64.0f); }
    f32x16 pA0, pA1, pB0, pB1, oa0, oa1, ob0, ob1;
#pragma unroll
    for (int r = 0; r < 16; ++r) { pA0[r] = 0.f; pA1[r] = 0.f; oa0[r] = 0.f; oa1[r] = 0.f; ob0[r] = 0.f; ob1[r] = 0.f; }
    float ma = 0.f, mb = 0.f, la = 0.f, lb = 0.f;
    {
        { u32x4 kN[2]; kN[0] = LDU(lds + kon[0]); kN[1] = LDU(lds + kon[1]);
          { const i32x8 k8 = CAT8(kN[0], kN[1]); pA0 = MFS(k8, qa8, pA0); pA1 = MFS(k8, qb8, pA1); }
#pragma unroll
          for (int j = 0; j < 2; ++j) { const bf16x8 k = LDF(lds + kor[j]); pA0 = MF32(k, qar[j], pA0); pA1 = MF32(k, qbr[j], pA1); } }
        if (!fast) {
            float ta, tb; M2_MAX_A(pA0, ta); M2_MAX_B(pA0, ta); M2_MAX_A(pA1, tb); M2_MAX_B(pA1, tb); ma = ta; mb = tb;
#pragma unroll
            for (int r = 0; r < 16; ++r) { pA0[r] -= ma; pA1[r] -= mb; }
        }
    }
    u32x4 kN[2]; bf16x8 kR[2];
    kN[0] = LDU(lds + 2048 + kon[0]); kN[1] = LDU(lds + 2048 + kon[1]); kR[0] = LDF(lds + 2048 + kor[0]); kR[1] = LDF(lds + 2048 + kor[1]);
#define M6_ARGS(A0, A1, B0, B1) A0, A1, B0, B1, oa0, oa1, ob0, ob1, ma, mb, la, lb, qa8, qb8, qar, qbr, kN, kR
#define M6_TILE(B, N, W, DO, TD) do { \
        mla8_step<true, true, true>(M6_ARGS(pA0, pA1, pB0, pB1), BUF3(B), BUF3(N), BUF3(N), kon, kor, vo0, dm, cs, BUF3(W), DO, TD, !fast); \
        mla8_step<true, true, false>(M6_ARGS(pB0, pB1, pA0, pA1), BUF3(B), BUF3(N) + 2048, BUF3(N) + 2048, kon, kor, vo1, dm, cs, BUF3(W), false, 0, !fast); } while (0)
#pragma nounroll
    for (int t = 0; t < NT - 1; t += 3) {
        M6_TILE(0, 1, 2, true, t + 2);
        M6_TILE(1, 2, 0, true, t + 3);
        M6_TILE(2, 0, 1, t + 4 < NT, t + 4);
    }
    mla8_step<true, false, true>(M6_ARGS(pA0, pA1, pB0, pB1), BUF3(0), BUF3(1), BUF3(1), kon, kor, vo0, dm, cs, BUF3(2), false, 0, !fast);
    mla8_step<false, false, false>(M6_ARGS(pB0, pB1, pA0, pA1), BUF3(0), BUF3(1), BUF3(1), kon, kor, vo1, dm, cs, BUF3(2), false, 0, !fast);
    la += __shfl_xor(la, 32); lb += __shfl_xor(lb, 32);
    const int lane_m = opaque((int)threadIdx.x) & 63, r32m = lane_m & 31, him = lane_m >> 5;
#pragma unroll
    for (int blk = 0; blk < 2; ++blk) {
        f32x16& o0 = blk ? ob0 : oa0; f32x16& o1 = blk ? ob1 : oa1; const float inv = 1.0f / (blk ? lb : la);
        float qs = 0.f;
#pragma unroll
        for (int r = 0; r < 16; ++r) { o0[r] *= inv; o1[r] *= inv; qs += o0[r] * o0[r] + o1[r] * o1[r]; }
        qs += __shfl_xor(qs, 32);
        if (him == 0) atomicAdd(ssqu + 64 * wv + 32 * blk + r32m, qs);
        bf16_t* orow = Ou + (size_t)(64 * wv + 32 * blk + r32m) * D + 4 * him;
#pragma unroll
        for (int g = 0; g < 4; ++g) {
            u32x2 w0, w1;
            w0.x = cvt_pk_bf16(o0[4 * g], o0[4 * g + 1]); w0.y = cvt_pk_bf16(o0[4 * g + 2], o0[4 * g + 3]); w1.x = cvt_pk_bf16(o1[4 * g], o1[4 * g + 1]); w1.y = cvt_pk_bf16(o1[4 * g + 2], o1[4 * g + 3]);
            *(u32x2*)(orow + 8 * g) = w0; *(u32x2*)(orow + 32 + 8 * g) = w1;
        }
    }
}

constexpr int WN_TILE = 16384, WN_VT = 8192;
template <bool MASK>
__device__ __forceinline__ void win_tile(const LAS unsigned char* tb, const int (&kon)[4], const int (&vo)[4], const bf16x8 (&q)[4], f32x16& o0, f32x16& o1, float& mrun, float& lrun, int dj) {
    f32x16 p0, p1;
#pragma unroll
    for (int r = 0; r < 16; ++r) { p0[r] = 0.f; p1[r] = 0.f; }
#pragma unroll
    for (int d0 = 0; d0 < 4; ++d0) { p0 = MF32(LDF(tb + kon[d0]), q[d0], p0); p1 = MF32(LDF(tb + kon[d0] + 4096), q[d0], p1); }
    if (MASK) {
#pragma unroll
        for (int r = 0; r < 16; ++r) { const int d = dj + (r & 7) + 16 * (r >> 3);
            if (d < -128 || d > 128) p0[r] = -INFINITY;
            if (d + 32 < -128 || d + 32 > 128) p1[r] = -INFINITY; }
    }
    float tm = max3f(p0[0], p1[0], p0[1]);
#pragma unroll
    for (int r = 1; r < 15; r += 2) { tm = max3f(tm, p1[r], p0[r + 1]); tm = max3f(tm, p1[r + 1], p0[r + 2 > 15 ? 15 : r + 2]); }
    tm = fmaxf(tm, p1[15]);
    tm = xhalf_max(tm);
    const float mn = fmaxf(mrun, tm), alpha = __builtin_amdgcn_exp2f(mrun - mn);
    mrun = mn;
    float rs = 0.f;
#pragma unroll
    for (int r = 0; r < 16; ++r) { p0[r] = __builtin_amdgcn_exp2f(p0[r] - mn); p1[r] = __builtin_amdgcn_exp2f(p1[r] - mn); rs += p0[r] + p1[r]; }
    lrun = lrun * alpha + rs;
#pragma unroll
    for (int r = 0; r < 16; ++r) { o0[r] *= alpha; o1[r] *= alpha; }
#pragma unroll
    for (int s = 0; s < 2; ++s) {
        u32x4 w0, w1;
        w0.x = cvt_pk_bf16(p0[8 * s + 0], p0[8 * s + 1]); w0.y = cvt_pk_bf16(p0[8 * s + 2], p0[8 * s + 3]); w0.z = cvt_pk_bf16(p0[8 * s + 4], p0[8 * s + 5]); w0.w = cvt_pk_bf16(p0[8 * s + 6], p0[8 * s + 7]);
        w1.x = cvt_pk_bf16(p1[8 * s + 0], p1[8 * s + 1]); w1.y = cvt_pk_bf16(p1[8 * s + 2], p1[8 * s + 3]); w1.z = cvt_pk_bf16(p1[8 * s + 4], p1[8 * s + 5]); w1.w = cvt_pk_bf16(p1[8 * s + 6], p1[8 * s + 7]);
        const bf16x8 b0 = __builtin_bit_cast(bf16x8, w0), b1 = __builtin_bit_cast(bf16x8, w1);
        o0 = MF32(LDF(tb + WN_VT + vo[s]), b0, o0); o1 = MF32(LDF(tb + WN_VT + vo[s] + 4096), b0, o1);
        o0 = MF32(LDF(tb + WN_VT + vo[2 + s]), b1, o0); o1 = MF32(LDF(tb + WN_VT + vo[2 + s] + 4096), b1, o1);
    }
}
__device__ __forceinline__ void win_phase(LAS unsigned char* lds, int vcu, int G, const bf16_t* Qa, const bf16_t* Ka, const bf16_t* VaT, const float* sink, bf16_t* attn_out, float* ssq_a) {
    const int tid = threadIdx.x, lane = tid & 63, r32 = lane & 31, hi = lane >> 5, wv = __builtin_amdgcn_readfirstlane(tid >> 6), hh = wv & 3, sub = wv >> 2;
    const int pr = (r32 & ~12) | ((r32 & 4) << 1) | ((r32 & 8) >> 1);
    int kon[4], vo[4];
#pragma unroll
    for (int d0 = 0; d0 < 4; ++d0) kon[d0] = pr * 128 + (((2 * d0 + hi) ^ ((pr >> 1) & 7)) << 4);
#pragma unroll
    for (int k = 0; k < 4; ++k) vo[k] = r32 * 128 + (((2 * k + hi) ^ ((r32 >> 1) & 7)) << 4);
    const int drow = 8 * wv + (lane >> 3), dlg = (lane & 7) ^ ((drow >> 1) & 7), dsrc = drow * 64 + dlg * 8;
    for (int su = vcu; su < 256; su += G) {
        const int bk = su >> 6, b = bk >> 1, kvh = bk & 1, j0 = (su & 63) * 4;
        const bf16_t* Kt = Ka + (size_t)bk * S * 64; const bf16_t* Vt = VaT + (size_t)bk * S * 64;
        __syncthreads();
#pragma unroll
        for (int i = 0; i < 8; ++i) { const int tile = j0 - 2 + i;
            if (tile >= 0 && tile < S / 64) {
                __builtin_amdgcn_global_load_lds((const unsigned*)(Kt + (size_t)tile * 4096 + dsrc), (LAS unsigned*)(lds + i * WN_TILE + wv * 1024), 16, 0, 0);
                __builtin_amdgcn_global_load_lds((const unsigned*)(Vt + (size_t)tile * 4096 + dsrc), (LAS unsigned*)(lds + i * WN_TILE + WN_VT + wv * 1024), 16, 0, 0);
            } }
        asm volatile("s_waitcnt vmcnt(0)" ::: "memory");
        __syncthreads();
        const int hd = kvh * 4 + hh; const float sink_l2 = sink[hd] * LOG2E;
        for (int u = 0; u < 4; ++u) {
            const int j = j0 + u, qw = 64 * j + 32 * sub;
            const bf16_t* Qw = Qa + ((size_t)b * S + qw) * 512 + hd * 64;
            bf16x8 q[4];
#pragma unroll
            for (int d0 = 0; d0 < 4; ++d0) q[d0] = *(const bf16x8*)(Qw + (size_t)r32 * 512 + d0 * 16 + hi * 8);
            float mrun = -1e30f, lrun = 0.f; f32x16 o0, o1;
#pragma unroll
            for (int r = 0; r < 16; ++r) { o0[r] = 0.f; o1[r] = 0.f; }
#pragma unroll
            for (int rel = -2; rel <= 2; ++rel) { const int tile = j + rel;
                if (tile >= 0 && tile < S / 64) { const LAS unsigned char* tb = lds + (u + rel + 2) * WN_TILE; const int dj = tile * 64 + 8 * hi - (qw + r32);
                    if (rel == -2 || rel == 2) win_tile<true>(tb, kon, vo, q, o0, o1, mrun, lrun, dj); else win_tile<false>(tb, kon, vo, q, o0, o1, mrun, lrun, dj); } }
            float ltot = lrun + __shfl_xor(lrun, 32);
            { const float mf = fmaxf(mrun, sink_l2), a = __builtin_amdgcn_exp2f(mrun - mf); ltot = ltot * a + __builtin_amdgcn_exp2f(sink_l2 - mf);
              const float inv = a / ltot; float qs = 0.f;
#pragma unroll
              for (int r = 0; r < 16; ++r) { o0[r] *= inv; o1[r] *= inv; qs += o0[r] * o0[r] + o1[r] * o1[r]; }
              qs += __shfl_xor(qs, 32);
              if (hi == 0) atomicAdd(ssq_a + (size_t)b * S + qw + r32, qs); }
            bf16_t* orow = attn_out + ((size_t)b * S + qw + r32) * D + hd * 64 + 4 * hi;
#pragma unroll
            for (int g = 0; g < 4; ++g) {
                u32x2 w0, w1; w0.x = cvt_pk_bf16(o0[4 * g], o0[4 * g + 1]); w0.y = cvt_pk_bf16(o0[4 * g + 2], o0[4 * g + 3]); w1.x = cvt_pk_bf16(o1[4 * g], o1[4 * g + 1]); w1.y = cvt_pk_bf16(o1[4 * g + 2], o1[4 * g + 3]);
                *(u32x2*)(orow + 8 * g) = w0; *(u32x2*)(orow + 32 + 8 * g) = w1;
            }
        }
    }
}

struct Args { const float* in[24]; const int* pos; float* out; unsigned char* ws; int ph_lo, ph_hi; };

struct ConvDesc { const float* colptr; size_t ldw; const float* ga; const float* gb; int gsplit, k0, K; bf16_t* dst; };
__device__ __forceinline__ void conv_load(const ConvDesc& d, float (&v)[32], int lane) {
#pragma unroll
    for (int i = 0; i < 32; ++i) { const int k = d.k0 + 2 * i + (lane >> 5); v[i] = d.colptr ? d.colptr[(size_t)k * d.ldw] : 0.f; }
}
__device__ __forceinline__ void conv_store(const ConvDesc& d, float (&v)[32], LAS float* scr, int lane) {
    if (d.ga) {
#pragma unroll
        for (int i = 0; i < 32; ++i) { const int k = d.k0 + 2 * i + (lane >> 5); v[i] *= (k < d.gsplit ? d.ga[k] : d.gb[k - d.gsplit]); }
    }
#pragma unroll
    for (int i = 0; i < 32; ++i) scr[(2 * i + (lane >> 5)) * 33 + (lane & 31)] = v[i];
    asm volatile("s_waitcnt lgkmcnt(0)" ::: "memory");
    const int c = lane & 7;
#pragma unroll
    for (int j = 0; j < 4; ++j) { const int n = (lane >> 3) + 8 * j; const LAS float* s = scr + (8 * c) * 33 + n;
        u32x4 o; o.x = cvt_pk_bf16(s[0 * 33], s[1 * 33]); o.y = cvt_pk_bf16(s[2 * 33], s[3 * 33]); o.z = cvt_pk_bf16(s[4 * 33], s[5 * 33]); o.w = cvt_pk_bf16(s[6 * 33], s[7 * 33]);
        *(u32x4*)(d.dst + (size_t)n * d.K + d.k0 + 8 * c) = o; }
    asm volatile("s_waitcnt lgkmcnt(0)" ::: "memory");
}
__device__ __forceinline__ int pairperm(int p, int half) {
    const int a = p >> 3, b = p & 7; return b < 4 ? 4 * a + b : half + 4 * a + (b - 4);
}

__global__ void __launch_bounds__(NWAVES * 64, 2) fwd_kernel(Args args) {
    extern __shared__ __attribute__((aligned(16))) unsigned char lds_raw[];
    LAS unsigned char* lds = (LAS unsigned char*)lds_raw;
    volatile LAS unsigned* MISC = (volatile LAS unsigned*)(lds + MISC_OFF);
    const int tid = threadIdx.x, lane = tid & 63, wave = __builtin_amdgcn_readfirstlane(tid >> 6);
    const int G = gridDim.x; const int bx = blockIdx.x; const int vcu = (G % 8 == 0) ? (bx % 8) * (G / 8) + bx / 8 : bx;
    unsigned char* ws = args.ws;
    unsigned* ctl = (unsigned*)(ws + WS_CTL);
    float* ctlf = (float*)(ws + WS_CTL);
    for (int u = tid; u < (LDS_BYTES - MISC_OFF) / 4; u += NWAVES * 64) ((LAS unsigned*)(lds + MISC_OFF))[u] = 0u;
    __syncthreads();
    XcdBarrier bar; bar.bar = ctl + CW_BAR; bar.x = 0; bar.st = nullptr;
    if (N_LAUNCHES == 1) bar = xcd_barrier_post(ctl + CW_BAR, MISC + 8);
    const int lo = args.ph_lo, hi_ph = args.ph_hi;
#ifndef PHMASK
#define PHMASK 0x1ff
#endif
#define IN(k) (((PHMASK >> (k)) & 1) && lo <= (k) && (k) < hi_ph)
#define SEAM(k) do { if (IN(k) && IN((k) + 1)) xcd_barrier(bar); } while (0)
    const int gw = vcu * NWAVES + wave, NGW = G * NWAVES;

    const float* x = args.in[0];
    bf16_t* W1t = (bf16_t*)(ws + WS_W1T); bf16_t* W2q = (bf16_t*)(ws + WS_W2Q); bf16_t* W2kv = (bf16_t*)(ws + WS_W2KV); bf16_t* W4t = (bf16_t*)(ws + WS_W4T);
    bf16_t* Wgu = (bf16_t*)(ws + WS_WGU); bf16_t* Wd = (bf16_t*)(ws + WS_WD); bf16_t* Wrt = (bf16_t*)(ws + WS_WRT);
    float* cosA = (float*)(ws + WS_COSA); float* sinA = (float*)(ws + WS_SINA); float* cosB = (float*)(ws + WS_COSB); float* sinB = (float*)(ws + WS_SINB);
    float* xstat = (float*)(ws + WS_XSTAT);
    bf16_t* h0b = (bf16_t*)(ws + WS_H0B); bf16_t* attn_out = (bf16_t*)(ws + WS_H0B); bf16_t* h1b = (bf16_t*)(ws + WS_H0B);
    bf16_t* cq = (bf16_t*)(ws + WS_CQ); bf16_t* hid = (bf16_t*)(ws + WS_CQ); bf16_t* ckv = (bf16_t*)(ws + WS_CKV);
    bf16_t* Qa = (bf16_t*)(ws + WS_QA); bf16_t* Ka = (bf16_t*)(ws + WS_KA); bf16_t* VaT = (bf16_t*)(ws + WS_VAT); bf16_t* Kr = (bf16_t*)(ws + WS_KR);
    bf16_t* Qb = (bf16_t*)(ws + WS_QB); bf16_t* Kn = (bf16_t*)(ws + WS_KN); bf16_t* VbT = (bf16_t*)(ws + WS_VBT); unsigned char* Qn8 = ws + WS_KN + 16 * MiB;
    bf16_t* h1pre = (bf16_t*)(ws + WS_H1PRE); bf16_t* ysl = (bf16_t*)(ws + WS_Y);
    unsigned* ltok = (unsigned*)(ws + WS_LTOK); float* lw = (float*)(ws + WS_LW);
    float* ssq_q = ctlf + CW_SSQ_Q; float* ssq_kv = ctlf + CW_SSQ_KV; float* ssq_a = ctlf + CW_SSQ_A; float* ssq_b = ctlf + CW_SSQ_B; float* s1 = ctlf + CW_S1; float* s2 = ctlf + CW_S2;

    constexpr int I0 = 16 * 64, I1 = 12 * 24, I2 = 4 * 32, I3 = 16 * 32, I4 = 32 * 256, I5 = 32 * 128, I6 = 16 * 2;
    constexpr int NITEMS = I0 + I1 + I2 + I3 + I4 + I5 + I6;
    const int nn = lane & 31;
    auto decode = [&](int r, ConvDesc& d) {
        d.ga = nullptr; d.gb = nullptr; d.gsplit = 0;
        if (r < I0) {
            const int kb = r / 64, nb = r % 64, n = nb * 32 + nn; int src;
            if (n < 640) src = (n & ~63) + pairperm(n & 63, 32); else if (n < 1792) src = n; else if (n < 1824) src = 1792 + pairperm(n - 1792, 16); else src = -1;
            d.colptr = src >= 0 ? args.in[4] + src : nullptr; d.ldw = IN_COLS; d.k0 = kb * 64; d.K = 1024; d.dst = W1t + (size_t)(nb * 32) * 1024; return; } r -= I0;
        if (r < I1) {
            const int kb = r / 24, nb = r % 24, n = nb * 32 + nn; int src;
            if (n < 512) src = (n >> 6) * 96 + (n & 63); else { const int hd = (n - 512) >> 5, p = (n - 512) & 31; src = hd * 96 + 64 + pairperm(p, 16); }
            d.colptr = args.in[7] + src; d.ldw = 768; d.ga = args.in[6]; d.gb = args.in[6]; d.gsplit = 1 << 30; d.k0 = kb * 64; d.K = 768; d.dst = W2q + (size_t)(nb * 32) * 768; return; } r -= I1;
        if (r < I2) {
            const int kb = r / 32, nb = r % 32, n = nb * 32 + nn; const int src = (n < 512) ? (n >> 6) * 128 + (n & 63) : ((n - 512) >> 6) * 128 + 64 + (n & 63);
            d.colptr = args.in[9] + src; d.ldw = 1024; d.ga = args.in[8]; d.gb = args.in[8]; d.gsplit = 1 << 30; d.k0 = kb * 64; d.K = 256; d.dst = W2kv + (size_t)(nb * 32) * 256; return; } r -= I2;
        if (r < I3) {
            const int kb = r / 32, nb = r % 32, n = nb * 32 + nn;
            d.colptr = args.in[12] + n; d.ldw = 1024; d.ga = args.in[10]; d.gb = args.in[11]; d.gsplit = 512; d.k0 = kb * 64; d.K = 1024; d.dst = W4t + (size_t)(nb * 32) * 1024; return; } r -= I3;
        if (r < I4) {
            const int e = r / 256, r2 = r % 256, kb = r2 / 16, nb = r2 % 16, n = nb * 32 + nn, qq = n >> 8, j = n & 255;
            d.colptr = (j < 128) ? args.in[19] + (size_t)e * 1024 * 256 + 128 * qq + j : args.in[20] + (size_t)e * 1024 * 256 + 128 * qq + (j - 128);
            d.ldw = 256; d.k0 = kb * 64; d.K = 1024; d.dst = Wgu + ((size_t)e * 512 + nb * 32) * 1024; return; } r -= I4;
        if (r < I5) {
            const int e = r / 128, r2 = r % 128, kb = r2 / 32, nb = r2 % 32, n = nb * 32 + nn;
            d.colptr = args.in[21] + (size_t)e * 256 * 1024 + n; d.ldw = 1024; d.k0 = kb * 64; d.K = 256; d.dst = Wd + ((size_t)e * 1024 + nb * 32) * 256; return; } r -= I5;
        {
            const int kb = r / 2, nb = r % 2, n = nb * 32 + nn;
            d.colptr = (n < 4) ? args.in[15] + n : (n < 36) ? args.in[17] + (n - 4) : nullptr; d.ldw = (n < 4) ? 4 : 32; d.k0 = kb * 64; d.K = 1024; d.dst = Wrt + (size_t)(nb * 32) * 1024;
        }
    };
#define CONV_RUN(n_, w_, nw_, MAP, scrp) do { ConvDesc dA, dB; float vA[32], vB[32]; int it = (w_); \
        if (it < (n_)) { decode(MAP(it), dA); conv_load(dA, vA, lane); } \
        while (it < (n_)) { const int itB = it + (nw_); \
            if (itB < (n_)) { decode(MAP(itB), dB); conv_load(dB, vB, lane); } \
            conv_store(dA, vA, (scrp), lane); \
            if (itB >= (n_)) break; \
            const int itA = itB + (nw_); \
            if (itA < (n_)) { decode(MAP(itA), dA); conv_load(dA, vA, lane); } \
            conv_store(dB, vB, (scrp), lane); \
            it = itA; } } while (0)
#define CONV_MAP_P0(i) ((i) < I0 + I1 + I2 + I3 ? (i) : (i) + I4 + I5)
#define CONV_MAP_MOE(i) ((i) + I0 + I1 + I2 + I3)
    if (IN(0)) {
        LAS float* scr = (LAS float*)(lds + wave * 16384);
        CONV_RUN(I0 + I1 + I2 + I3 + I6, gw, NGW, CONV_MAP_P0, scr);
        {
            const int j = lane & 31; const float inv = 1.0f / powf(10000.0f, (float)(2 * j) / 64.0f);
            for (int i = gw * 64 + lane; i < T * 32; i += NGW * 64) {
                const int tok = i >> 5; const float ang = (float)args.pos[tok] * inv;
                const double rev = (double)ang * 0.15915494309189535; const float fr = (float)(rev - rint(rev));
                const float cs = __builtin_amdgcn_cosf(fr), sn = __builtin_amdgcn_sinf(fr);
                cosA[(size_t)tok * 32 + j] = cs; sinA[(size_t)tok * 32 + j] = sn;
                if ((j & 1) == 0) { cosB[(size_t)tok * 16 + (j >> 1)] = cs; sinB[(size_t)tok * 16 + (j >> 1)] = sn; }
            }
        }
        {
            f32x4 g[4], bb[4];
#pragma unroll
            for (int j = 0; j < 4; ++j) { g[j] = *(const f32x4*)(args.in[2] + 4 * lane + 256 * j); bb[j] = *(const f32x4*)(args.in[3] + 4 * lane + 256 * j); }
            for (int row0 = gw * 4; row0 < T; row0 += NGW * 4) {
                f32x4 v[4][4]; float s[4], q[4];
#pragma unroll
                for (int r = 0; r < 4; ++r) { const f32x4* xr = (const f32x4*)(x + (size_t)(row0 + r) * D) + lane;
#pragma unroll
                    for (int j = 0; j < 4; ++j) v[r][j] = xr[64 * j]; }
#pragma unroll
                for (int r = 0; r < 4; ++r) { s[r] = 0.f;
#pragma unroll
                    for (int j = 0; j < 4; ++j) s[r] += (v[r][j][0] + v[r][j][1]) + (v[r][j][2] + v[r][j][3]); }
#pragma unroll
                for (int o = 1; o < 64; o <<= 1) {
#pragma unroll
                    for (int r = 0; r < 4; ++r) s[r] += __shfl_xor(s[r], o); }
#pragma unroll
                for (int r = 0; r < 4; ++r) { s[r] *= (1.f / D); q[r] = 0.f;
#pragma unroll
                    for (int j = 0; j < 4; ++j) { v[r][j] = v[r][j] - s[r]; q[r] += sq4(v[r][j]); } }
#pragma unroll
                for (int o = 1; o < 64; o <<= 1) {
#pragma unroll
                    for (int r = 0; r < 4; ++r) q[r] += __shfl_xor(q[r], o); }
#pragma unroll
                for (int r = 0; r < 4; ++r) { const float rstd = fast_rsqrt(q[r] * (1.f / D) + LN_EPS);
                    u32x2* o8 = (u32x2*)(h0b + (size_t)(row0 + r) * D) + lane;
#pragma unroll
                    for (int j = 0; j < 4; ++j) { const f32x4 y = v[r][j] * rstd * g[j] + bb[j]; u32x2 w; w.x = cvt_pk_bf16(y[0], y[1]); w.y = cvt_pk_bf16(y[2], y[3]); o8[64 * j] = w; }
                    if (lane == 0) { xstat[2 * (row0 + r)] = s[r]; xstat[2 * (row0 + r) + 1] = rstd; } }
            }
        }
    }
    SEAM(0);
    if (IN(1)) {
        pg8::DenseSched<D> Sd; Sd.init(h0b, W1t, T, N1, G, bx);
        Epi1 E{Qa, Ka, VaT, cq, ckv, Kr, ssq_q, ssq_kv, cosA, sinA, cosB, sinB, ctl + CW_KR2};
        pg8::gemm_phase<Epi1, pg8::DenseSched<D>, true, D>(lds, Sd, E);
    }
    SEAM(1);
    if (IN(2)) {
        { pg8::DenseSched<768> Sd; Sd.init(cq, W2q, T, 768, G, bx); Epi2q E{Qb, Qn8, ssq_q, cosB, sinB}; pg8::gemm_phase<Epi2q, pg8::DenseSched<768>, true, 768>(lds, Sd, E); }
        __syncthreads();
        { pg8::DenseSched<256> Sd; Sd.init(ckv, W2kv, T, 1024, G, bx); Epi2kv E{Kn, VbT, ssq_kv, ctl + CW_KN2}; pg8::gemm_phase<Epi2kv, pg8::DenseSched<256>, true, 256>(lds, Sd, E); }
    }
    SEAM(2);
    if (IN(3)) {
        for (int u = vcu; u < 512; u += G) {
            const int bh = u >> 5, b = bh >> 3, hd = bh & 7, q0 = (u & 31) * 512;
            const MlaSrc cs{(const bf16_t*)((const unsigned char*)Kn + (size_t)bh * S * 64), Kr + (size_t)b * S * 32, VbT + (size_t)bh * S * 64};
            const float kn_bound = sqrtf(__uint_as_float(ctl[CW_KN2 + bh * 2]) + __uint_as_float(ctl[CW_KN2 + bh * 2 + 1])) * 1.01f, kr_bound = sqrtf(__uint_as_float(ctl[CW_KR2 + b])) * 1.01f;
            mla8_unit(lds, Qb + ((size_t)b * S + q0) * 768 + hd * 96, Qn8 + ((size_t)b * S + q0) * 512 + hd * 64, cs, kn_bound, kr_bound, attn_out + ((size_t)b * S + q0) * D + 512 + hd * 64, ssq_b + (size_t)b * S + q0);
        }
        win_phase(lds, vcu, G, Qa, Ka, VaT, args.in[5], attn_out, ssq_a);
        __syncthreads();
    }
    SEAM(3);
    if (IN(4)) {
        pg8::DenseSched<D> Sd; Sd.init(attn_out, W4t, T, D, G, bx);
        Epi4 E{x, xstat, args.in[2], args.in[3], ssq_a, ssq_b, h1pre, s1, s2};
        pg8::gemm_phase<Epi4, pg8::DenseSched<D>, true, D>(lds, Sd, E);
    }
    SEAM(4);
    if (IN(5)) {
        LAS unsigned char* wl = lds + wave * 16896;
        constexpr int NCV_HI = (I4 + I5) / 3 * 2;
        if (wave >= 4) { CONV_RUN(NCV_HI, (wave - 4) * G + vcu, 4 * G, CONV_MAP_MOE, (LAS float*)wl); }
        const int r32 = lane & 31, hi = lane >> 5;
        for (int grp = wave * G + vcu; grp < T / 32; grp += NGW) {
            const int row0 = grp * 32;
            float mu_l, rs_l;
            { const float a = s1[row0 + r32] * (1.f / D), bq = s2[row0 + r32] * (1.f / D); mu_l = a; rs_l = fast_rsqrt(fmaxf(bq - a * a, 0.f) + LN_EPS); }
            f32x16 a0, a1;
#pragma unroll
            for (int r = 0; r < 16; ++r) { a0[r] = 0.f; a1[r] = 0.f; }
            for (int c = 0; c < 4; ++c) {
                const int col = 256 * c + 4 * lane;
                const bf16_t* wb0 = Wrt + (size_t)r32 * 1024 + 256 * c + 8 * hi; const bf16_t* wb1 = wb0 + 32 * 1024;
                bf16x8 blo[16];
#pragma unroll
                for (int ks = 0; ks < 8; ++ks) { blo[2 * ks] = *(const bf16x8*)(wb0 + 16 * ks); blo[2 * ks + 1] = *(const bf16x8*)(wb1 + 16 * ks); }
                const f32x4 g = *(const f32x4*)(args.in[13] + col), bb = *(const f32x4*)(args.in[14] + col);
                __builtin_amdgcn_sched_barrier(0);
                { u32x2 hv[32];
                  const bf16_t* rp = h1pre + (size_t)row0 * D + col;
#pragma unroll
                  for (int r = 0; r < 32; ++r) hv[r] = *(const u32x2*)(rp + (size_t)r * D);
                  __builtin_amdgcn_sched_barrier(0);
                  bf16_t* wp = h1b + (size_t)row0 * D + col;
#pragma unroll
                  for (int r = 0; r < 32; ++r) {
                    const float mu = __shfl(mu_l, r), rs = __shfl(rs_l, r);
                    const f32x4 v = (f32x4){bf_lo(hv[r].x), bf_hi(hv[r].x), bf_lo(hv[r].y), bf_hi(hv[r].y)};
                    const f32x4 y = (v - mu) * rs * g + bb;
                    u32x2 w; w.x = cvt_pk_bf16(y[0], y[1]); w.y = cvt_pk_bf16(y[2], y[3]);
                    *(u32x2*)(wp + (size_t)r * D) = w;
                    *(LAS u32x2*)(wl + r * 528 + lane * 8) = w;
                  } }
                __builtin_amdgcn_sched_barrier(0);
#pragma unroll
                for (int ks = 0; ks < 8; ++ks) {
                    const bf16x8 af = *(const LAS bf16x8*)(wl + r32 * 528 + (16 * ks + 8 * hi) * 2);
                    a0 = __builtin_amdgcn_mfma_f32_32x32x16_bf16(af, blo[2 * ks], a0, 0, 0, 0);
                    a1 = __builtin_amdgcn_mfma_f32_32x32x16_bf16(af, blo[2 * ks + 1], a1, 0, 0, 0);
                }
#pragma unroll 4
                for (int ks = 8; ks < 16; ++ks) {
                    const bf16x8 af = *(const LAS bf16x8*)(wl + r32 * 528 + (16 * ks + 8 * hi) * 2);
                    const bf16x8 b0 = *(const bf16x8*)(wb0 + 16 * ks), b1 = *(const bf16x8*)(wb1 + 16 * ks);
                    a0 = __builtin_amdgcn_mfma_f32_32x32x16_bf16(af, b0, a0, 0, 0, 0);
                    a1 = __builtin_amdgcn_mfma_f32_32x32x16_bf16(af, b1, a1, 0, 0, 0);
                }
            }
            LAS float* sl = (LAS float*)wl;
#pragma unroll
            for (int r = 0; r < 16; ++r) { const int rowr = (r & 3) + 8 * (r >> 2) + 4 * hi; sl[rowr * 40 + r32] = a0[r]; if (r32 < 4) sl[rowr * 40 + 32 + r32] = a1[r]; }
            asm volatile("s_waitcnt lgkmcnt(0)" ::: "memory");
            if (lane < 32) {
                const int tok = row0 + lane; const LAS float* lr = sl + lane * 40;
                float gl[4];
#pragma unroll
                for (int j = 0; j < 4; ++j) gl[j] = lr[j] + args.in[16][j];
                int gi = 0; float gm = gl[0];
#pragma unroll
                for (int j = 1; j < 4; ++j) if (gl[j] > gm) { gm = gl[j]; gi = j; }
                float gs = 0.f;
#pragma unroll
                for (int j = 0; j < 4; ++j) gs += __expf(gl[j] - gm);
                const float pg = 1.0f / gs;
                float el[8];
#pragma unroll
                for (int j = 0; j < 8; ++j) el[j] = lr[4 + 8 * gi + j] + args.in[18][8 * gi + j];
                int i1 = 0; float v1 = el[0];
#pragma unroll
                for (int j = 1; j < 8; ++j) if (el[j] > v1) { v1 = el[j]; i1 = j; }
                int i2 = (i1 == 0) ? 1 : 0; float v2 = (i1 == 0) ? el[1] : el[0];
#pragma unroll
                for (int j = 1; j < 8; ++j) if (j != i1 && el[j] > v2) { v2 = el[j]; i2 = j; }
                const float tt = __expf(v2 - v1), w1 = pg / (1.0f + tt), w2 = pg * tt / (1.0f + tt);
                const int e1 = 8 * gi + i1, e2 = 8 * gi + i2;
                const unsigned p1 = atomicAdd(ctl + CW_ECNT + 64 * e1, 1u); ltok[(size_t)e1 * T + p1] = (unsigned)tok; lw[(size_t)e1 * T + p1] = w1;
                const unsigned p2 = atomicAdd(ctl + CW_ECNT + 64 * e2, 1u); ltok[(size_t)e2 * T + p2] = (unsigned)tok | 0x8000u; lw[(size_t)e2 * T + p2] = w2;
            }
            asm volatile("s_waitcnt lgkmcnt(0)" ::: "memory");
        }
#define CONV_MAP_MOE_LO(i) ((i) + I0 + I1 + I2 + I3 + NCV_HI)
        if (wave < 4) { CONV_RUN(I4 + I5 - NCV_HI, wave * G + vcu, 4 * G, CONV_MAP_MOE_LO, (LAS float*)wl); }
        __syncthreads();
    }
    SEAM(5);
    LAS int* tab = (LAS int*)(lds + MISC_OFF + 256);
    if (IN(6) || IN(7)) {
        if (tid < 32) { const int c = (int)__hip_atomic_load(ctl + CW_ECNT + 64 * tid, RLX_AGENT); tab[64 + tid] = c; tab[128 + tid] = (c + 255) >> 8; }
        __syncthreads();
        if (tid == 0) { int acc = 0; for (int e = 0; e < 32; ++e) { tab[e] = acc; acc += tab[128 + e]; } tab[32] = acc; }
        __syncthreads();
    }
    if (IN(6)) {
        MoeSched<0> Sm{tab, h1b, Wgu, ltok, G, bx, 2};
        EpiGU E{hid};
        pg8::gemm_phase<EpiGU, MoeSched<0>, true, D>(lds, Sm, E);
    }
    SEAM(6);
    if (IN(7)) {
        MoeSched<1> Sm{tab, hid, Wd, ltok, G, bx, 4};
        EpiD E{ltok, lw, ysl};
        pg8::gemm_phase<EpiD, MoeSched<1>, true, EFF>(lds, Sm, E);
    }
    SEAM(7);
    if (IN(8)) {
        f32x4 g1[4], b1[4], g2[4], b2[4];
#pragma unroll
        for (int j = 0; j < 4; ++j) { const int col = 4 * lane + 256 * j; g1[j] = *(const f32x4*)(args.in[13] + col); b1[j] = *(const f32x4*)(args.in[14] + col); g2[j] = *(const f32x4*)(args.in[22] + col); b2[j] = *(const f32x4*)(args.in[23] + col); }
        for (int row = gw; row < T; row += NGW) {
            const float mu1 = s1[row] * (1.f / D), rs1 = fast_rsqrt(fmaxf(s2[row] * (1.f / D) - mu1 * mu1, 0.f) + LN_EPS);
            f32x4 v[4]; float s = 0.f;
#pragma unroll
            for (int j = 0; j < 4; ++j) { const int col = 4 * lane + 256 * j;
                const u32x2 hv = *(const u32x2*)(h1pre + (size_t)row * D + col); const f32x4 hp = (f32x4){bf_lo(hv.x), bf_hi(hv.x), bf_lo(hv.y), bf_hi(hv.y)};
                const u32x2 ya = *(const u32x2*)(ysl + (size_t)row * D + col), yb = *(const u32x2*)(ysl + (size_t)T * D + (size_t)row * D + col);
                const f32x4 h1 = (hp - mu1) * rs1 * g1[j] + b1[j];
                f32x4 y; y[0] = bf_lo(ya.x) + bf_lo(yb.x); y[1] = bf_hi(ya.x) + bf_hi(yb.x); y[2] = bf_lo(ya.y) + bf_lo(yb.y); y[3] = bf_hi(ya.y) + bf_hi(yb.y);
                v[j] = h1 * DN_ALPHA + y; s += (v[j][0] + v[j][1]) + (v[j][2] + v[j][3]); }
            const float mean = wave_sum(s) * (1.f / D); float q = 0.f;
#pragma unroll
            for (int j = 0; j < 4; ++j) { v[j] = v[j] - mean; q += sq4(v[j]); }
            const float rstd = fast_rsqrt(wave_sum(q) * (1.f / D) + LN_EPS);
#pragma unroll
            for (int j = 0; j < 4; ++j) *(f32x4*)(args.out + (size_t)row * D + 4 * lane + 256 * j) = v[j] * rstd * g2[j] + b2[j];
        }
    }
#undef IN
#undef SEAM
}

extern "C" void kernel_launch(void* const* d_in, const int* in_sizes, int n_in, void* d_out, int out_size, void* d_ws, size_t ws_size, hipStream_t stream) {
    static int grid = 0;
    if (grid == 0) {
        if (n_in != 24 || in_sizes[0] != T * D || out_size != T * D || ws_size < WS_END) { fprintf(stderr, "kernel_launch: unexpected shapes (n_in %d, in0 %d, out %d, ws %zu)\n", n_in, n_in > 0 ? in_sizes[0] : -1, out_size, ws_size); grid = -1; return; }
        int dev = 0, cus = 0, per_cu = 0;
        if (hipGetDevice(&dev) != hipSuccess || hipDeviceGetAttribute(&cus, hipDeviceAttributeMultiprocessorCount, dev) != hipSuccess) { grid = -1; return; }
        if (hipFuncSetAttribute((const void*)fwd_kernel, hipFuncAttributeMaxDynamicSharedMemorySize, LDS_BYTES) != hipSuccess) { fprintf(stderr, "kernel_launch: hipFuncSetAttribute failed\n"); grid = -1; return; }
        if (hipOccupancyMaxActiveBlocksPerMultiprocessor(&per_cu, (const void*)fwd_kernel, NWAVES * 64, LDS_BYTES) != hipSuccess || per_cu < 1)
            fprintf(stderr, "kernel_launch: note: occupancy query reports %d workgroups per CU\n", per_cu);
        (void)hipGetLastError();
        grid = cus;
    }
    if (grid < 0) return;
    if (hipMemsetAsync((char*)d_ws + WS_CTL, 0, CTL_ZERO_BYTES, stream) != hipSuccess) return;
    Args a{};
    for (int i = 0; i < 24; ++i) a.in[i] = (const float*)d_in[i];
    a.pos = (const int*)d_in[1]; a.out = (float*)d_out; a.ws = (unsigned char*)d_ws;
    if (N_LAUNCHES == 1) { a.ph_lo = 0; a.ph_hi = N_PHASES; hipLaunchKernelGGL(fwd_kernel, dim3(grid), dim3(NWAVES * 64), LDS_BYTES, stream, a); }
    else for (int p = 0; p < N_PHASES; ++p) { a.ph_lo = p; a.ph_hi = p + 1; hipLaunchKernelGGL(fwd_kernel, dim3(grid), dim3(NWAVES * 64), LDS_BYTES, stream, a); }
}
```

```cpp
#include <hip/hip_runtime.h>
#include <cstdio>
#include <cstdint>

#ifndef MK_N_LAUNCHES
#define MK_N_LAUNCHES 1
#endif
constexpr int N_PHASES = 9;
constexpr int N_LAUNCHES = MK_N_LAUNCHES;

#define LAS __attribute__((address_space(3)))
#define GAS __attribute__((address_space(1)))
typedef unsigned short bf16_t;
typedef short bf16x8 __attribute__((ext_vector_type(8)));
typedef float f32x4 __attribute__((ext_vector_type(4)));
typedef float f32x16 __attribute__((ext_vector_type(16)));
typedef unsigned u32x4 __attribute__((ext_vector_type(4)));
typedef unsigned u32x2 __attribute__((ext_vector_type(2)));

constexpr int NB = 2, S = 16384, T = NB * S, D = 1024;
constexpr int IN_COLS = 1824, N1 = 2048;
constexpr int NEXP = 32, EFF = 256;
constexpr float LN_EPS = 1e-5f, RMS_EPS = 1e-6f;
constexpr float DN_ALPHA = 1.189207115002721f;
constexpr float LOG2E = 1.4426950408889634f;
constexpr float SC_A = 0.125f * LOG2E;
constexpr float Q8_PRE = 2.0f, K8_PRE = 0.5f;
constexpr float SC_B = 0.10206207261596575f * LOG2E;

constexpr size_t MiB = 1u << 20;
constexpr size_t WS_CTL = 0, CTL_ZERO_BYTES = 1 * MiB;
constexpr size_t WS_XSTAT = 1 * MiB;
constexpr size_t WS_WRT = 1 * MiB + 512 * 1024;
constexpr size_t WS_COSA = 2 * MiB, WS_SINA = 6 * MiB, WS_COSB = 10 * MiB, WS_SINB = 12 * MiB;
constexpr size_t WS_W1T = 14 * MiB, WS_W2Q = 18 * MiB, WS_W2KV = 20 * MiB, WS_W4T = 21 * MiB, WS_WGU = 23 * MiB, WS_WD = 55 * MiB;
constexpr size_t WS_LTOK = 71 * MiB, WS_LW = 75 * MiB;
constexpr size_t WS_H0B = 80 * MiB;
constexpr size_t WS_CQ = 144 * MiB;
constexpr size_t WS_CKV = 192 * MiB;
constexpr size_t WS_QA = 208 * MiB, WS_KA = 240 * MiB, WS_VAT = 248 * MiB, WS_KR = 256 * MiB;
constexpr size_t WS_QB = 260 * MiB, WS_KN = 308 * MiB, WS_VBT = 340 * MiB;
constexpr size_t WS_H1PRE = 372 * MiB;
constexpr size_t WS_Y = 208 * MiB;
constexpr size_t WS_END = 500 * MiB;
constexpr int CW_BAR = 4096;
constexpr int CW_ECNT = 8192;
constexpr int CW_KN2 = 10240, CW_KR2 = 10240 + 64;
constexpr int CW_SSQ_Q = 65536, CW_SSQ_KV = CW_SSQ_Q + T, CW_SSQ_A = CW_SSQ_KV + T, CW_SSQ_B = CW_SSQ_A + T, CW_S1 = CW_SSQ_B + T, CW_S2 = CW_S1 + T;
static_assert((size_t)(CW_S2 + T) * 4 <= CTL_ZERO_BYTES, "ctl");

constexpr int RING_BYTES = 135168;
constexpr int MISC_OFF = RING_BYTES;
constexpr int LDS_BYTES = 147456;
constexpr int NWAVES = 8;

#define RLX_AGENT __ATOMIC_RELAXED, __HIP_MEMORY_SCOPE_AGENT
typedef float f32x2_t __attribute__((ext_vector_type(2))); typedef __bf16 bf16x2_t __attribute__((ext_vector_type(2)));
__device__ __forceinline__ unsigned cvt_pk_bf16(float lo, float hi) { const f32x2_t v = {lo, hi}; const bf16x2_t b = __builtin_convertvector(v, bf16x2_t); return __builtin_bit_cast(unsigned, b); }
__device__ __forceinline__ float bf_lo(unsigned w) { return __uint_as_float(w << 16); }
__device__ __forceinline__ float bf_hi(unsigned w) { return __uint_as_float(w & 0xffff0000u); }
__device__ __forceinline__ float wave_sum(float v) {
#pragma unroll
    for (int o = 1; o < 64; o <<= 1) v += __shfl_xor(v, o);
    return v;
}
__device__ __forceinline__ float fast_rsqrt(float x) { return 1.0f / sqrtf(x); }
__device__ __forceinline__ void wave_amax_nonneg(unsigned* p, float v, int lane) {
#pragma unroll
    for (int o = 1; o < 64; o <<= 1) v = fmaxf(v, __shfl_xor(v, o));
    if (lane == 0) atomicMax(p, __float_as_uint(v));
}
__device__ __forceinline__ int opaque(int v) { asm volatile("" : "+v"(v)); return v; }

#define XB_TMO      128
#define XB_XCNT(j)  (256  + 64 * (j))
#define XB_XSUB(j)  (1280 + 64 * (j))
#define XB_XGEN(j)  (2304 + 64 * (j))
#define XB_TOP      3328
#define XB_TOPGEN   3392
#define XCD_BAR_WORDS 3456
#define XB_SPIN_CAP (1u << 20)
__device__ __forceinline__ unsigned xb_ld(unsigned* p)              { return __hip_atomic_load(p, __ATOMIC_RELAXED, __HIP_MEMORY_SCOPE_AGENT); }
__device__ __forceinline__ unsigned xb_add(unsigned* p, unsigned v) { return __hip_atomic_fetch_add(p, v, __ATOMIC_RELAXED, __HIP_MEMORY_SCOPE_AGENT); }
__device__ __forceinline__ unsigned xb_xcc_id() { return (unsigned)__builtin_amdgcn_s_getreg((3 << 11) | 20) & 0xFu; }
#define XB_SPIN(cond, bar) do { unsigned _sp = 0; while (cond) { __builtin_amdgcn_s_sleep(1); \
    if ((++_sp & 255u) == 0u) { if (xb_ld(&(bar)[XB_TMO])) break; if (_sp > XB_SPIN_CAP) { atomicAdd(&(bar)[XB_TMO], 1u); break; } } } } while (0)
struct XcdBarrier { unsigned* bar; unsigned x; volatile LAS unsigned* st; };
__device__ __forceinline__ XcdBarrier xcd_barrier_post(unsigned* bar, volatile LAS unsigned* st) {
    XcdBarrier b; b.bar = bar; b.x = xb_xcc_id(); b.st = st;
    if (threadIdx.x == 0) (void)xb_add(&bar[XB_XCNT(b.x)], 1u);
    return b;
}
__device__ __forceinline__ void xcd_barrier_complete(unsigned* bar, unsigned x, unsigned& nloc, unsigned& nx) {
    const unsigned G = gridDim.x * gridDim.y * gridDim.z;
    unsigned sum, cnt, mine, sp = 0u;
    for (;;) {
        sum = 0u; cnt = 0u; mine = 0u;
#pragma unroll
        for (unsigned j = 0; j < 16; ++j) { const unsigned c = xb_ld(&bar[XB_XCNT(j)]); sum += c; cnt += (c > 0u) ? 1u : 0u; mine = (j == x) ? c : mine; }
        if (sum == G) break;
        __builtin_amdgcn_s_sleep(1);
        if ((++sp & 255u) == 0u) { if (xb_ld(&bar[XB_TMO])) break; if (sp > XB_SPIN_CAP) { atomicAdd(&bar[XB_TMO], 1u); break; } }
    }
    nloc = mine > 0u ? mine : 1u; nx = cnt > 0u ? cnt : 1u;
}
__device__ __forceinline__ void xcd_barrier(const XcdBarrier& b) {
    asm volatile("s_waitcnt vmcnt(0)" ::: "memory");
    __syncthreads();
    if (threadIdx.x == 0) {
        unsigned* bar = b.bar;
        __builtin_amdgcn_s_waitcnt(0);
        unsigned nloc = b.st[0], nx = b.st[1];
        if (nloc == 0u) { xcd_barrier_complete(bar, b.x, nloc, nx); b.st[0] = nloc; b.st[1] = nx; }
        const unsigned old = xb_add(&bar[XB_XSUB(b.x)], 1u);
        const unsigned gen = old / nloc;
        if (old + 1u == (gen + 1u) * nloc) {
            __builtin_amdgcn_fence(__ATOMIC_RELEASE, "agent");
            asm volatile("s_waitcnt vmcnt(0)" ::: "memory");
            const unsigned og = xb_add(&bar[XB_TOP], 1u);
            const unsigned tg = og / nx;
            if (og + 1u == (tg + 1u) * nx) xb_add(&bar[XB_TOPGEN], 1u);
            else XB_SPIN(xb_ld(&bar[XB_TOPGEN]) == tg, bar);
            __builtin_amdgcn_fence(__ATOMIC_ACQUIRE, "agent");
            xb_add(&bar[XB_XGEN(b.x)], 1u);
            asm volatile("s_waitcnt vmcnt(0)" ::: "memory");
        } else {
            XB_SPIN(xb_ld(&bar[XB_XGEN(b.x)]) == gen, bar);
            __builtin_amdgcn_fence(__ATOMIC_ACQUIRE, "agent");
            asm volatile("s_waitcnt vmcnt(0)" ::: "memory");
        }
    }
    __syncthreads();
}

namespace pg8 {
constexpr int BM = 256, BK = 64, HALF = 128, HTB = HALF * BK * 2, STAGE_BYTES = 8 * HTB, NXCD = 8, WGM = 8;
__device__ __forceinline__ int lds_byte(int r, int c) { const int st = (r >> 4) * 2 + (c >> 5), rr = r & 15, cc = c & 31, ob = rr * 64 + cc * 2; return st * 1024 + (ob ^ (((ob >> 9) & 1) << 5)); }
__device__ __forceinline__ void stage_rc(int b, int& R, int& C) { const int st = b / 1024, sb = b % 1024, swz = sb ^ (((sb >> 9) & 1) << 5); R = (st >> 1) * 16 + swz / 64; C = (st & 1) * 32 + (swz % 64) / 2; }
__device__ __forceinline__ int perm32(int rho) { const int n = rho >> 4, i = rho & 15; return 8 * (i >> 2) + 4 * n + (i & 3); }

struct Unit { int pm, pn, e, chunk, cnt; };

template <int K> struct DenseSched {
    static constexpr bool GATHER = false;
    const bf16_t* A; const bf16_t* Bt; int nM, nN, nwg, G, c;
    __device__ void init(const bf16_t* A_, const bf16_t* Bt_, int M, int N, int G_, int c_) { A = A_; Bt = Bt_; nM = M / BM; nN = N / BM; nwg = nM * nN; G = G_; c = c_; }
    __device__ bool next(int i, Unit& u) const {
        const long L = (long)i * G + c; if (L >= nwg) return false;
        int wgid = (int)L; { const int q = nwg / NXCD, r = nwg % NXCD, xcd = wgid % NXCD, off = wgid / NXCD; wgid = (xcd < r ? xcd * (q + 1) : r * (q + 1) + (xcd - r) * q) + off; }
        const int nig = WGM * nN, gid = wgid / nig, fm = gid * WGM, gsz = (nM - fm) < WGM ? (nM - fm) : WGM;
        u.pm = fm + ((wgid % nig) % gsz); u.pn = (wgid % nig) / gsz; u.e = 0; u.chunk = 0; u.cnt = 0; return true;
    }
    __device__ __forceinline__ const char* a_base(const Unit& u) const { return (const char*)A + (size_t)u.pm * BM * K * 2; }
    __device__ __forceinline__ const char* b_base(const Unit& u) const { return (const char*)Bt + (size_t)u.pn * BM * K * 2; }
    __device__ __forceinline__ void a_offs(const Unit&, const int (&R)[2], const int (&C)[2], unsigned (&v0)[2], unsigned (&v1)[2]) const {
#pragma unroll
        for (int i = 0; i < 2; ++i) { v0[i] = (unsigned)(R[i] * K + C[i]) * 2u; v1[i] = v0[i] + (unsigned)(HALF * K) * 2u; }
    }
};

template <class Epi, class Sched, bool ALIGN_EPI, int K>
__device__ __forceinline__ void gemm_phase(LAS unsigned char* lds, const Sched& S, const Epi& E) {
    const int tid = threadIdx.x, wid = __builtin_amdgcn_readfirstlane(tid >> 6), lane = tid & 63, wr = wid >> 2, wc = wid & 3, fr = lane & 15, fq = lane >> 4;
    constexpr int nt = K / BK;
    unsigned voffB[2]; int Rs[2], Cs[2];
#pragma unroll
    for (int i = 0; i < 2; ++i) { int R, C; stage_rc(tid * 16 + i * 8192, R, C); Rs[i] = R; Cs[i] = C; const int Rb = Epi::PERM ? ((R & ~31) + perm32(R & 31)) : R;
        voffB[i] = (unsigned)(Rb * K + C) * 2u; }
    const size_t kstep = (size_t)(BK * 2);
    const size_t hstepB = (size_t)HALF * K * 2;
    const unsigned ldsw = (unsigned)wid * 1024u;
    const int aoff = lds_byte(wr * 64 + fr, fq * 8), boff = lds_byte(wc * 32 + fr, fq * 8);
#define PG8_SA(b, h) (((b) * 2 + (h)) * HTB)
#define PG8_SB(b, h) ((4 + (b) * 2 + (h)) * HTB)
#define PG8_STAGE(bufoff, gbase, voff) do { _Pragma("unroll") for (int _i = 0; _i < 2; ++_i) \
        __builtin_amdgcn_global_load_lds((const unsigned*)((const char*)(gbase) + (voff)[_i]), (LAS unsigned*)(lds + (bufoff) + ldsw + _i * 8192), 16, 0, 0); } while (0)
#define PG8_LDA(dst, b, h) do { _Pragma("unroll") for (int m = 0; m < 4; ++m) _Pragma("unroll") for (int k = 0; k < 2; ++k) dst[m][k] = *(const LAS bf16x8*)(lds + PG8_SA(b, h) + aoff + m * 2048 + k * 1024); } while (0)
#define PG8_LDB(dst, b, h) do { _Pragma("unroll") for (int n = 0; n < 2; ++n) _Pragma("unroll") for (int k = 0; k < 2; ++k) dst[n][k] = *(const LAS bf16x8*)(lds + PG8_SB(b, h) + boff + n * 2048 + k * 1024); } while (0)
#define PG8_MMA(ai, bj, At, Bt) do { __builtin_amdgcn_s_setprio(1); _Pragma("unroll") for (int m = 0; m < 4; ++m) _Pragma("unroll") for (int n = 0; n < 2; ++n) _Pragma("unroll") for (int k = 0; k < 2; ++k) \
        acc[ai][bj][m][n] = __builtin_amdgcn_mfma_f32_16x16x32_bf16(Bt[n][k], At[m][k], acc[ai][bj][m][n], 0, 0, 0); __builtin_amdgcn_s_setprio(0); } while (0)
#define PG8_WAIT_V(n) asm volatile("s_waitcnt vmcnt(" #n ")" ::: "memory")
#define PG8_WAIT_L(n) asm volatile("s_waitcnt lgkmcnt(" #n ")" ::: "memory")
#define PG8_BAR __builtin_amdgcn_s_barrier()
#define PG8_SCHED __builtin_amdgcn_sched_barrier(0)
    Unit cur, nxt; int ui = 0;
    if (!S.next(0, cur)) return;
    f32x4 acc[2][2][4][2];
#pragma unroll
    for (int a = 0; a < 2; ++a)
#pragma unroll
        for (int b = 0; b < 2; ++b)
#pragma unroll
            for (int m = 0; m < 4; ++m)
#pragma unroll
                for (int n = 0; n < 2; ++n) acc[a][b][m][n] = (f32x4){0.f, 0.f, 0.f, 0.f};
    bf16x8 At[4][2], B0[2][2], B1[2][2];
    unsigned vA0[2], vA1[2], nA0[2], nA1[2];
    S.a_offs(cur, Rs, Cs, vA0, vA1);
    const char* cA = S.a_base(cur); const char* cB = S.b_base(cur);
    PG8_STAGE(PG8_SB(0, 0), cB, voffB); PG8_STAGE(PG8_SB(0, 1), cB + hstepB, voffB); PG8_STAGE(PG8_SA(0, 0), cA, vA0); PG8_STAGE(PG8_SA(0, 1), cA, vA1);
    if (wr == 1) PG8_BAR;
    PG8_WAIT_V(2); PG8_BAR;
    PG8_STAGE(PG8_SB(1, 0), cB + kstep, voffB); PG8_STAGE(PG8_SA(1, 0), cA + kstep, vA0); PG8_STAGE(PG8_SB(1, 1), cB + hstepB + kstep, voffB);
    PG8_WAIT_V(6); PG8_BAR;
    for (;;) {
        const bool has_next = S.next(ui + 1, nxt);
        const char* nA = has_next ? S.a_base(nxt) : cA; const char* nB = has_next ? S.b_base(nxt) : cB;
        if constexpr (Sched::GATHER) {
            if (has_next) S.a_offs(nxt, Rs, Cs, nA0, nA1);
            else {
#pragma unroll
                for (int i = 0; i < 2; ++i) { nA0[i] = vA0[i]; nA1[i] = vA1[i]; }
            }
        }
#pragma nounroll
        for (int t = 0; t < nt; t += 2) {
            const bool last = (t == nt - 2);
            if constexpr (Epi::MIDK) { if (t == nt / 2) E.mid(acc, cur, wr, wc, fr, fq); }
            const char* a1 = cA + (size_t)(t + 1) * kstep;
            const char* a2 = last ? nA : cA + (size_t)(t + 2) * kstep; const char* b2 = last ? nB : cB + (size_t)(t + 2) * kstep;
            const char* a3 = a2 + kstep; const char* b3 = b2 + kstep;
            unsigned s0[2], s1[2];
            if constexpr (Sched::GATHER) {
#pragma unroll
                for (int i = 0; i < 2; ++i) { s0[i] = last ? nA0[i] : vA0[i]; s1[i] = last ? nA1[i] : vA1[i]; }
            } else {
#pragma unroll
                for (int i = 0; i < 2; ++i) { s0[i] = vA0[i]; s1[i] = vA1[i]; }
            }
            PG8_LDB(B0, 0, 0); PG8_LDB(B1, 0, 1); PG8_SCHED; PG8_LDA(At, 0, 0); PG8_STAGE(PG8_SA(1, 1), a1, vA1);
            PG8_WAIT_V(8); PG8_WAIT_L(0); PG8_BAR; PG8_MMA(0, 0, At, B0); PG8_MMA(0, 1, At, B1); PG8_BAR; PG8_SCHED;
            PG8_LDA(At, 0, 1); PG8_STAGE(PG8_SB(0, 0), b2, voffB); PG8_STAGE(PG8_SB(0, 1), b2 + hstepB, voffB); PG8_STAGE(PG8_SA(0, 0), a2, s0);
            PG8_WAIT_V(8); PG8_WAIT_L(0); PG8_BAR; PG8_MMA(1, 0, At, B0); PG8_MMA(1, 1, At, B1); PG8_BAR; PG8_SCHED;
            PG8_LDB(B0, 1, 0); PG8_LDB(B1, 1, 1); PG8_SCHED; PG8_LDA(At, 1, 0); PG8_STAGE(PG8_SA(0, 1), a2, s1);
            PG8_WAIT_V(8); PG8_WAIT_L(0); PG8_BAR; PG8_MMA(0, 0, At, B0); PG8_MMA(0, 1, At, B1); PG8_BAR; PG8_SCHED;
            PG8_LDA(At, 1, 1); PG8_STAGE(PG8_SB(1, 0), b3, voffB); PG8_STAGE(PG8_SB(1, 1), b3 + hstepB, voffB); PG8_STAGE(PG8_SA(1, 0), a3, s0);
            PG8_WAIT_V(8); PG8_WAIT_L(0); PG8_BAR; PG8_MMA(1, 0, At, B0); PG8_MMA(1, 1, At, B1); PG8_BAR; PG8_SCHED;
        }
        if constexpr (ALIGN_EPI) { if (wr == 0) PG8_BAR; }
        E(acc, cur, wr, wc, fr, fq);
        if (!has_next) break;
#pragma unroll
        for (int a = 0; a < 2; ++a)
#pragma unroll
            for (int b = 0; b < 2; ++b)
#pragma unroll
                for (int m = 0; m < 4; ++m)
#pragma unroll
                    for (int n = 0; n < 2; ++n) acc[a][b][m][n] = (f32x4){0.f, 0.f, 0.f, 0.f};
        cur = nxt; cA = nA; cB = nB; ++ui;
        if constexpr (Sched::GATHER) {
#pragma unroll
            for (int i = 0; i < 2; ++i) { vA0[i] = nA0[i]; vA1[i] = nA1[i]; }
        }
        if constexpr (ALIGN_EPI) { if (wr == 1) PG8_BAR; }
    }
    PG8_WAIT_V(0);
    if constexpr (!ALIGN_EPI) { if (wr == 0) PG8_BAR; }
    PG8_BAR;
#undef PG8_SA
#undef PG8_SB
#undef PG8_STAGE
#undef PG8_LDA
#undef PG8_LDB
#undef PG8_MMA
#undef PG8_WAIT_V
#undef PG8_WAIT_L
#undef PG8_BAR
#undef PG8_SCHED
}
}
using pg8::Unit;

__device__ __forceinline__ u32x2 pack8_fp8(const f32x4 a, const f32x4 b, float sc);
__device__ __forceinline__ u32x2 rope4_fp8(const f32x4 x1, const f32x4 x2, const f32x4 c, const f32x4 s, float sc) {
    const f32x4 o1 = x1 * c - x2 * s, o2 = x1 * s + x2 * c; return pack8_fp8(o1, o2, sc);
}
__device__ __forceinline__ void rope4(const f32x4 x1, const f32x4 x2, const f32x4 c, const f32x4 s, float sc, u32x4& w) {
    const f32x4 o1 = (x1 * c - x2 * s) * sc, o2 = (x1 * s + x2 * c) * sc;
    w.x = cvt_pk_bf16(o1[0], o1[1]); w.y = cvt_pk_bf16(o1[2], o1[3]); w.z = cvt_pk_bf16(o2[0], o2[1]); w.w = cvt_pk_bf16(o2[2], o2[3]);
}
__device__ __forceinline__ u32x4 pack8(const f32x4 a, const f32x4 b, float sc) {
    u32x4 w; w.x = cvt_pk_bf16(a[0] * sc, a[1] * sc); w.y = cvt_pk_bf16(a[2] * sc, a[3] * sc); w.z = cvt_pk_bf16(b[0] * sc, b[1] * sc); w.w = cvt_pk_bf16(b[2] * sc, b[3] * sc); return w;
}
__device__ __forceinline__ u32x2 pack8_fp8(const f32x4 a, const f32x4 b, float sc) {
    int w0 = __builtin_amdgcn_cvt_pk_fp8_f32(a[0] * sc, a[1] * sc, 0, false); w0 = __builtin_amdgcn_cvt_pk_fp8_f32(a[2] * sc, a[3] * sc, w0, true);
    int w1 = __builtin_amdgcn_cvt_pk_fp8_f32(b[0] * sc, b[1] * sc, 0, false); w1 = __builtin_amdgcn_cvt_pk_fp8_f32(b[2] * sc, b[3] * sc, w1, true);
    u32x2 w; w.x = (unsigned)w0; w.y = (unsigned)w1; return w;
}
__device__ __forceinline__ float sq4(const f32x4 a) { return (a[0] * a[0] + a[1] * a[1]) + (a[2] * a[2] + a[3] * a[3]); }
__device__ __forceinline__ void store_vt8(bf16_t* base, const f32x4 a, const f32x4 b, float sc) {
    const u32x4 w = pack8(a, b, sc);
    base[0 * 64] = (bf16_t)(w.x & 0xffff); base[1 * 64] = (bf16_t)(w.x >> 16); base[2 * 64] = (bf16_t)(w.y & 0xffff); base[3 * 64] = (bf16_t)(w.y >> 16);
    base[4 * 64] = (bf16_t)(w.z & 0xffff); base[5 * 64] = (bf16_t)(w.z >> 16); base[6 * 64] = (bf16_t)(w.w & 0xffff); base[7 * 64] = (bf16_t)(w.w >> 16);
}

struct Epi1 {
    static constexpr bool PERM = true, MIDK = false;
    bf16_t *Qa, *Ka, *VaT, *cq, *ckv, *Kr; float *ssq_q, *ssq_kv; const float *cosA, *sinA, *cosB, *sinB; unsigned* kr2;
    __device__ __forceinline__ void mid(f32x4 (&)[2][2][4][2], const Unit&, int, int, int, int) const {}
    __device__ __forceinline__ void operator()(const f32x4 (&acc)[2][2][4][2], const Unit& u, int wr, int wc, int fr, int fq) const {
        const int pn = u.pn, row0 = opaque(u.pm * 256 + wr * 64 + fr);
        if (pn < 2) {
#pragma unroll
            for (int ai = 0; ai < 2; ++ai)
#pragma unroll
                for (int m = 0; m < 4; ++m) { const int row = row0 + ai * 128 + m * 16; const int a = (wc & 1) * 4 + fq;
                    const f32x4 c = *(const f32x4*)(cosA + (size_t)row * 32 + 4 * a), s = *(const f32x4*)(sinA + (size_t)row * 32 + 4 * a);
#pragma unroll
                    for (int bj = 0; bj < 2; ++bj) { const int hd = pn * 4 + bj * 2 + (wc >> 1); u32x4 w; rope4(acc[ai][bj][m][0], acc[ai][bj][m][1], c, s, SC_A, w);
                        *(u32x4*)(Qa + (size_t)row * 512 + hd * 64 + 8 * a) = w; } }
        } else if (pn == 2) {
#pragma unroll
            for (int ai = 0; ai < 2; ++ai)
#pragma unroll
                for (int m = 0; m < 4; ++m) { const int row = row0 + ai * 128 + m * 16; const int a = (wc & 1) * 4 + fq, kvh = wc >> 1, b = row / S, s_ = row % S;
                    const f32x4 c = *(const f32x4*)(cosA + (size_t)row * 32 + 4 * a), s = *(const f32x4*)(sinA + (size_t)row * 32 + 4 * a);
                    u32x4 w; rope4(acc[ai][0][m][0], acc[ai][0][m][1], c, s, 1.0f, w);
                    *(u32x4*)(Ka + ((size_t)(b * 2 + kvh) * S + s_) * 64 + 8 * a) = w;
                    store_vt8(VaT + ((size_t)(b * 2 + kvh) * (S / 64) + (s_ >> 6)) * 4096 + (size_t)(8 * a) * 64 + (s_ & 63), acc[ai][1][m][0], acc[ai][1][m][1], 1.0f); }
        } else if (pn < 7) {
            bf16_t* dst = (pn < 6) ? cq : ckv; const int ld = (pn < 6) ? 768 : 256; const int cbase = (pn < 6) ? (pn - 3) * 256 : 0; float* ssq = (pn < 6) ? ssq_q : ssq_kv;
#pragma unroll
            for (int ai = 0; ai < 2; ++ai)
#pragma unroll
                for (int m = 0; m < 4; ++m) { const int row = row0 + ai * 128 + m * 16; float q = 0.f;
#pragma unroll
                    for (int bj = 0; bj < 2; ++bj) { *(u32x4*)(dst + (size_t)row * ld + cbase + bj * 128 + wc * 32 + fq * 8) = pack8(acc[ai][bj][m][0], acc[ai][bj][m][1], 1.0f);
                        q += sq4(acc[ai][bj][m][0]) + sq4(acc[ai][bj][m][1]); }
                    q += __shfl_xor(q, 16); q += __shfl_xor(q, 32);
                    if (fq == 0) atomicAdd(ssq + row, q); }
        } else {
            if (wc == 0) {
                float nmax = 0.f;
#pragma unroll
                for (int ai = 0; ai < 2; ++ai)
#pragma unroll
                    for (int m = 0; m < 4; ++m) { const int row = row0 + ai * 128 + m * 16;
                        const f32x4 c = *(const f32x4*)(cosB + (size_t)row * 16 + 4 * fq), s = *(const f32x4*)(sinB + (size_t)row * 16 + 4 * fq);
                        *(u32x2*)((unsigned char*)Kr + (size_t)row * 32 + 8 * fq) = rope4_fp8(acc[ai][0][m][0], acc[ai][0][m][1], c, s, K8_PRE);
                        float q = sq4(acc[ai][0][m][0]) + sq4(acc[ai][0][m][1]);
                        q += __shfl_xor(q, 16); q += __shfl_xor(q, 32); nmax = fmaxf(nmax, q); }
                wave_amax_nonneg(kr2 + (u.pm * 256) / S, nmax, (fq << 4) | fr);
            }
        }
    }
};
struct Epi2q {
    static constexpr bool PERM = true, MIDK = false;
    bf16_t* Qb; unsigned char* Qn8; const float* ssq_q; const float *cosB, *sinB;
    __device__ __forceinline__ void mid(f32x4 (&)[2][2][4][2], const Unit&, int, int, int, int) const {}
    __device__ __forceinline__ void operator()(const f32x4 (&acc)[2][2][4][2], const Unit& u, int wr, int wc, int fr, int fq) const {
        const int pn = u.pn, row0 = opaque(u.pm * 256 + wr * 64 + fr);
#pragma unroll
        for (int ai = 0; ai < 2; ++ai)
#pragma unroll
            for (int m = 0; m < 4; ++m) { const int row = row0 + ai * 128 + m * 16;
                const float rs = fast_rsqrt(ssq_q[row] * (1.0f / 768.0f) + RMS_EPS) * SC_B;
                if (pn < 2) {
#pragma unroll
                    for (int bj = 0; bj < 2; ++bj) { const int hd = pn * 4 + bj * 2 + (wc >> 1), d0 = (wc & 1) * 32 + 8 * fq;
                        *(u32x2*)(Qn8 + (size_t)row * 512 + hd * 64 + d0) = pack8_fp8(acc[ai][bj][m][0], acc[ai][bj][m][1], rs * Q8_PRE); }
                } else {
                    const f32x4 c = *(const f32x4*)(cosB + (size_t)row * 16 + 4 * fq), s = *(const f32x4*)(sinB + (size_t)row * 16 + 4 * fq);
#pragma unroll
                    for (int bj = 0; bj < 2; ++bj) { const int hd = bj * 4 + wc;
                        *(u32x2*)((unsigned char*)Qb + (size_t)row * 256 + hd * 32 + 8 * fq) = rope4_fp8(acc[ai][bj][m][0], acc[ai][bj][m][1], c, s, rs * Q8_PRE); }
                }
            }
    }
};
struct Epi2kv {
    static constexpr bool PERM = true, MIDK = false;
    bf16_t *Kn, *VbT; const float* ssq_kv; unsigned* kn2;
    __device__ __forceinline__ void mid(f32x4 (&)[2][2][4][2], const Unit&, int, int, int, int) const {}
    __device__ __forceinline__ void operator()(const f32x4 (&acc)[2][2][4][2], const Unit& u, int wr, int wc, int fr, int fq) const {
        const int pn = u.pn, row0 = opaque(u.pm * 256 + wr * 64 + fr);
        float nmax[2] = {0.f, 0.f};
#pragma unroll
        for (int ai = 0; ai < 2; ++ai)
#pragma unroll
            for (int m = 0; m < 4; ++m) { const int row = row0 + ai * 128 + m * 16, b = row / S, s_ = row % S;
                const float rs = fast_rsqrt(ssq_kv[row] * (1.0f / 256.0f) + RMS_EPS);
#pragma unroll
                for (int bj = 0; bj < 2; ++bj) { const int hd = (pn & 1) * 4 + bj * 2 + (wc >> 1), d0 = (wc & 1) * 32 + 8 * fq;
                    if (pn < 2) { *(u32x2*)((unsigned char*)Kn + ((size_t)(b * 8 + hd) * S + s_) * 64 + d0) = pack8_fp8(acc[ai][bj][m][0], acc[ai][bj][m][1], rs * K8_PRE);
                        float q = (sq4(acc[ai][bj][m][0]) + sq4(acc[ai][bj][m][1])) * rs * rs;
                        q += __shfl_xor(q, 16); q += __shfl_xor(q, 32); nmax[bj] = fmaxf(nmax[bj], q); }
                    else store_vt8(VbT + ((size_t)(b * 8 + hd) * (S / 64) + (s_ >> 6)) * 4096 + (size_t)d0 * 64 + (s_ & 63), acc[ai][bj][m][0], acc[ai][bj][m][1], rs); }
            }
        if (pn < 2) {
#pragma unroll
            for (int bj = 0; bj < 2; ++bj) wave_amax_nonneg(kn2 + ((size_t)((u.pm * 256) / S) * 8 + pn * 4 + bj * 2 + (wc >> 1)) * 2 + (wc & 1), nmax[bj], (fq << 4) | fr);
        }
    }
};
struct Epi4 {
    static constexpr bool PERM = true, MIDK = true;
    const float *x, *xstat, *g0, *b0, *ssq_a, *ssq_b; bf16_t* h1pre; float *s1, *s2;
    __device__ __forceinline__ void mid(f32x4 (&acc)[2][2][4][2], const Unit& u, int wr, int wc, int fr, int fq) const {
        const int row0 = opaque(u.pm * 256 + wr * 64 + fr);
#pragma unroll
        for (int ai = 0; ai < 2; ++ai)
#pragma unroll
            for (int m = 0; m < 4; ++m) { const int row = row0 + ai * 128 + m * 16;
                const float va = ssq_a[row] * (1.0f / 512.0f) + RMS_EPS, vb = ssq_b[row] * (1.0f / 512.0f) + RMS_EPS;
                const float ratio = sqrtf(vb / va);
#pragma unroll
                for (int bj = 0; bj < 2; ++bj)
#pragma unroll
                    for (int n = 0; n < 2; ++n) acc[ai][bj][m][n] *= ratio; }
    }
    __device__ __forceinline__ void operator()(const f32x4 (&acc)[2][2][4][2], const Unit& u, int wr, int wc, int fr, int fq) const {
        const int row0 = opaque(u.pm * 256 + wr * 64 + fr), col0 = u.pn * 256 + wc * 32 + 8 * fq;
#pragma unroll
        for (int ai = 0; ai < 2; ++ai)
#pragma unroll
            for (int m = 0; m < 4; ++m) { const int row = row0 + ai * 128 + m * 16;
                const float rb = fast_rsqrt(ssq_b[row] * (1.0f / 512.0f) + RMS_EPS);
                const float mean = xstat[2 * row], rstd = xstat[2 * row + 1];
                float t1 = 0.f, t2 = 0.f;
#pragma unroll
                for (int bj = 0; bj < 2; ++bj) { f32x4 v[2];
#pragma unroll
                    for (int n = 0; n < 2; ++n) { const int col = col0 + bj * 128 + n * 4;
                        const f32x4 xv = *(const f32x4*)(x + (size_t)row * D + col), g = *(const f32x4*)(g0 + col), b = *(const f32x4*)(b0 + col);
                        const f32x4 h0 = (xv - mean) * rstd * g + b;
                        v[n] = h0 * DN_ALPHA + acc[ai][bj][m][n] * rb;
                        t1 += (v[n][0] + v[n][1]) + (v[n][2] + v[n][3]); t2 += sq4(v[n]); }
                    *(u32x4*)(h1pre + (size_t)row * D + col0 + bj * 128) = pack8(v[0], v[1], 1.0f); }
                t1 += __shfl_xor(t1, 16); t1 += __shfl_xor(t1, 32); t2 += __shfl_xor(t2, 16); t2 += __shfl_xor(t2, 32);
                if (fq == 0) { atomicAdd(s1 + row, t1); atomicAdd(s2 + row, t2); } }
    }
};
struct EpiGU {
    static constexpr bool PERM = true, MIDK = false;
    bf16_t* hid;
    __device__ __forceinline__ void mid(f32x4 (&)[2][2][4][2], const Unit&, int, int, int, int) const {}
    __device__ __forceinline__ void operator()(const f32x4 (&acc)[2][2][4][2], const Unit& u, int wr, int wc, int fr, int fq) const {
        const int row0 = opaque(u.pm * 256 + wr * 64 + fr), col = u.pn * 128 + wc * 32 + fq * 8;
#pragma unroll
        for (int ai = 0; ai < 2; ++ai)
#pragma unroll
            for (int m = 0; m < 4; ++m) { const int row = row0 + ai * 128 + m * 16; f32x4 h[2];
#pragma unroll
                for (int n = 0; n < 2; ++n)
#pragma unroll
                    for (int e = 0; e < 4; ++e) { const float g = acc[ai][0][m][n][e], up = acc[ai][1][m][n][e]; h[n][e] = g * up / (1.0f + __builtin_amdgcn_exp2f(-g * LOG2E)); }
                *(u32x4*)(hid + (size_t)row * EFF + col) = pack8(h[0], h[1], 1.0f); }
    }
};
struct EpiD {
    static constexpr bool PERM = true, MIDK = false;
    const unsigned* ltok; const float* lw; bf16_t* y;
    __device__ __forceinline__ void mid(f32x4 (&)[2][2][4][2], const Unit&, int, int, int, int) const {}
    __device__ __forceinline__ void operator()(const f32x4 (&acc)[2][2][4][2], const Unit& u, int wr, int wc, int fr, int fq) const {
        const int i0 = opaque(wr * 64 + fr), col0 = u.pn * 256 + wc * 32 + fq * 8;
#pragma unroll
        for (int ai = 0; ai < 2; ++ai)
#pragma unroll
            for (int m = 0; m < 4; ++m) { const int li = u.chunk * 256 + i0 + ai * 128 + m * 16;
                if (li < u.cnt) { const unsigned ent = ltok[(size_t)u.e * T + li]; const float w = lw[(size_t)u.e * T + li];
                    bf16_t* dst = y + (size_t)(ent >> 15) * ((size_t)T * D) + (size_t)(ent & 0x7fffu) * D + col0;
#pragma unroll
                    for (int bj = 0; bj < 2; ++bj) *(u32x4*)(dst + bj * 128) = pack8(acc[ai][bj][m][0], acc[ai][bj][m][1], w); } }
    }
};

template <int MODE> struct MoeSched {
    static constexpr bool GATHER = (MODE == 0);
    const LAS int* tab;
    const bf16_t* A; const bf16_t* W; const unsigned* ltok; int G, c, npn;
    __device__ bool next(int i, Unit& u) const {
        const int ntl = tab[32]; const long L = (long)i * G + c; if (L >= (long)ntl * npn) return false;
        const int tau = (int)(L / npn); int e = 0;
        for (int k = 1; k < 32; ++k) e += (tab[k] <= tau) ? 1 : 0;
        u.pm = tau; u.pn = (int)(L % npn); u.e = e; u.chunk = tau - tab[e]; u.cnt = tab[64 + e]; return true;
    }
    __device__ __forceinline__ const char* a_base(const Unit& u) const { return MODE == 0 ? (const char*)A : (const char*)A + (size_t)u.pm * 256 * EFF * 2; }
    __device__ __forceinline__ const char* b_base(const Unit& u) const {
        return MODE == 0 ? (const char*)W + ((size_t)u.e * 512 + (size_t)u.pn * 256) * D * 2 : (const char*)W + ((size_t)u.e * D + (size_t)u.pn * 256) * EFF * 2; }
    __device__ __forceinline__ void a_offs(const Unit& u, const int (&R)[2], const int (&C)[2], unsigned (&v0)[2], unsigned (&v1)[2]) const {
        if constexpr (MODE == 0) {
#pragma unroll
            for (int i = 0; i < 2; ++i) { const int l0 = u.chunk * 256 + R[i], l1 = l0 + 128;
                const unsigned t0 = l0 < u.cnt ? (ltok[(size_t)u.e * T + l0] & 0x7fffu) : 0u, t1 = l1 < u.cnt ? (ltok[(size_t)u.e * T + l1] & 0x7fffu) : 0u;
                v0[i] = (t0 * (unsigned)D + (unsigned)C[i]) * 2u; v1[i] = (t1 * (unsigned)D + (unsigned)C[i]) * 2u; }
        } else {
#pragma unroll
            for (int i = 0; i < 2; ++i) { v0[i] = (unsigned)(R[i] * EFF + C[i]) * 2u; v1[i] = v0[i] + (unsigned)(128 * EFF) * 2u; }
        }
    }
};

#define MF32(a, b, c) __builtin_amdgcn_mfma_f32_32x32x16_bf16(a, b, c, 0, 0, 0)
#define SBAR() __builtin_amdgcn_sched_barrier(0)
#define LDF(p) (*(const LAS bf16x8*)(p))
__device__ __forceinline__ float max3f(float a, float b, float c) { return fmaxf(fmaxf(a, b), c); }
__device__ __forceinline__ float fadd_s(float a, float b) { float r; asm("v_add_f32_e32 %0, %1, %2" : "=v"(r) : "v"(a), "v"(b)); return r; }
__device__ __forceinline__ float xhalf_max(float v) { auto rr = __builtin_amdgcn_permlane32_swap(__float_as_uint(v), __float_as_uint(v), false, false); return fmaxf(__uint_as_float(rr[0]), __uint_as_float(rr[1])); }
constexpr float MLA_THRL = 8.0f;
#define PIN2(a, b) asm volatile("" : "+v"(a), "+v"(b))
struct MlaSrc { const bf16_t *Kn, *Krp, *Vt; };
struct MlaDma { int ko, ro, r8, wv; };
typedef float f32x2 __attribute__((ext_vector_type(2)));
#define M2_MAX_A(SN, TM) do { float a_ = max3f(SN[0], SN[1], SN[2]), b_ = max3f(SN[3], SN[4], SN[5]); a_ = max3f(a_, SN[6], SN[7]); b_ = max3f(b_, SN[8], SN[9]); TM = fmaxf(a_, b_); } while (0)
#define M2_MAX_B(SN, TM) do { float a_ = max3f(SN[10], SN[11], SN[12]); TM = max3f(TM, SN[13], SN[14]); a_ = fmaxf(a_, SN[15]); TM = fmaxf(TM, a_); TM = xhalf_max(TM); } while (0)
#define M4_E(C, j) do { C[4 * (j) + 0] = __builtin_amdgcn_exp2f(C[4 * (j) + 0]); C[4 * (j) + 1] = __builtin_amdgcn_exp2f(C[4 * (j) + 1]); C[4 * (j) + 2] = __builtin_amdgcn_exp2f(C[4 * (j) + 2]); C[4 * (j) + 3] = __builtin_amdgcn_exp2f(C[4 * (j) + 3]); } while (0)
#define M4_F(C, j, S0, S1, W0, W1) do { S0 = fadd_s(S0, C[4 * (j) + 0]); S1 = fadd_s(S1, C[4 * (j) + 1]); S0 = fadd_s(S0, C[4 * (j) + 2]); S1 = fadd_s(S1, C[4 * (j) + 3]); \
    if ((j) < 2) { W0[2 * ((j) & 1)] = cvt_pk_bf16(C[4 * (j) + 0], C[4 * (j) + 1]); W0[2 * ((j) & 1) + 1] = cvt_pk_bf16(C[4 * (j) + 2], C[4 * (j) + 3]); PIN2(W0[2 * ((j) & 1)], W0[2 * ((j) & 1) + 1]); } \
    else { W1[2 * ((j) & 1)] = cvt_pk_bf16(C[4 * (j) + 0], C[4 * (j) + 1]); W1[2 * ((j) & 1) + 1] = cvt_pk_bf16(C[4 * (j) + 2], C[4 * (j) + 3]); PIN2(W1[2 * ((j) & 1)], W1[2 * ((j) & 1) + 1]); } } while (0)
constexpr int AT3_KR = 4096, AT3_VT = 6144, AT3_BUF = 14336;
#define BUF3(k) (lds + (k) * AT3_BUF)
typedef int i32x8 __attribute__((ext_vector_type(8)));
#define MFS(a, b, c) __builtin_amdgcn_mfma_scale_f32_32x32x64_f8f6f4(a, b, c, 0, 0, 0, 127, 0, 127)
#define CAT8(x, y) ((i32x8){(int)(x)[0], (int)(x)[1], (int)(x)[2], (int)(x)[3], (int)(y)[0], (int)(y)[1], (int)(y)[2], (int)(y)[3]})
#define LDU(p) (*(const LAS u32x4*)(p))
#define MF8(a, b, c) __builtin_amdgcn_mfma_f32_32x32x16_fp8_fp8(a, b, c, 0, 0, 0)
#define PK64(lo, hi) ((long)(((unsigned long long)(hi) << 32) | (unsigned long long)(lo)))
#define KR8(j) PK64(kR[2 * (j)], kR[2 * (j) + 1])
__device__ __forceinline__ void mla_dma8(const MlaDma& dm, const MlaSrc& s, LAS unsigned char* buf, int t) {
    __builtin_amdgcn_global_load_lds((const unsigned*)(s.Vt + (size_t)t * 4096 + dm.ko), (LAS unsigned*)(buf + AT3_VT + dm.wv * 1024), 16, 0, 0);
    if (dm.wv < 4) __builtin_amdgcn_global_load_lds((const unsigned*)((const unsigned char*)s.Kn + (size_t)t * 4096 + dm.ro * 2), (LAS unsigned*)(buf + dm.wv * 1024), 16, 0, 0);
    else if (dm.wv < 6) __builtin_amdgcn_global_load_lds((const unsigned*)((const unsigned char*)s.Krp + (size_t)t * 2048 + dm.r8), (LAS unsigned*)(buf + AT3_KR + (dm.wv - 4) * 1024), 16, 0, 0);
}
template <bool HAS_NEXT, bool PRELOAD, bool BAR>
__device__ __forceinline__ void mla8_step(f32x16& ca, f32x16& cb, f32x16& na, f32x16& nb, f32x16& oa0, f32x16& oa1, f32x16& ob0, f32x16& ob1,
                                          float& ma, float& mb, float& la, float& lb, const i32x8& qa8, const i32x8& qb8, const long (&qar)[2], const long (&qbr)[2], u32x4 (&kN)[2], u32x4& kR,
                                          const LAS unsigned char* vbuf, const LAS unsigned char* nkn, const LAS unsigned char* nkr, const int (&kon)[2], int kor, const int (&vo)[2],
                                          const MlaDma& dm, const MlaSrc& dsrc, LAS unsigned char* wbuf, bool do_dma, int tdma, bool track) {
    float sa0 = 0.f, sa1 = 0.f, sb0 = 0.f, sb1 = 0.f; u32x4 pa0, pa1, pb0, pb1; bf16x8 vf[4];
    f32x16 zero16;
#pragma unroll
    for (int r = 0; r < 16; ++r) zero16[r] = 0.f;
    if (HAS_NEXT) {
        const i32x8 k8 = CAT8(kN[0], kN[1]);
        na = MFS(k8, qa8, zero16); SBAR();
        vf[0] = LDF(vbuf + vo[0]); vf[2] = LDF(vbuf + vo[0] + 4096); vf[1] = LDF(vbuf + vo[1]); vf[3] = LDF(vbuf + vo[1] + 4096);
        M4_E(ca, 0); M4_E(ca, 1); SBAR();
        nb = MFS(k8, qb8, zero16); M4_F(ca, 0, sa0, sa1, pa0, pa1); M4_E(ca, 2); SBAR();
        na = MF8(KR8(0), qar[0], na); M4_F(ca, 1, sa0, sa1, pa0, pa1); SBAR();
        nb = MF8(KR8(0), qbr[0], nb); M4_E(ca, 3); SBAR();
        na = MF8(KR8(1), qar[1], na); M4_F(ca, 2, sa0, sa1, pa0, pa1); SBAR();
        nb = MF8(KR8(1), qbr[1], nb); M4_F(ca, 3, sa0, sa1, pa0, pa1); SBAR();
    } else {
        vf[0] = LDF(vbuf + vo[0]); vf[2] = LDF(vbuf + vo[0] + 4096); vf[1] = LDF(vbuf + vo[1]); vf[3] = LDF(vbuf + vo[1] + 4096);
        M4_E(ca, 0); M4_E(ca, 1); M4_E(ca, 2); M4_E(ca, 3);
        M4_F(ca, 0, sa0, sa1, pa0, pa1); M4_F(ca, 1, sa0, sa1, pa0, pa1); M4_F(ca, 2, sa0, sa1, pa0, pa1); M4_F(ca, 3, sa0, sa1, pa0, pa1);
    }
    if (BAR) {
        asm volatile("s_waitcnt vmcnt(0)" ::: "memory");
        __syncthreads();
        if (do_dma) mla_dma8(dm, dsrc, wbuf, tdma);
    }
    SBAR();
    const bf16x8 xa0 = __builtin_bit_cast(bf16x8, pa0), xa1 = __builtin_bit_cast(bf16x8, pa1);
    oa0 = MF32(vf[0], xa0, oa0); SBAR();
    if (PRELOAD) { kN[0] = LDU(nkn + kon[0]); kN[1] = LDU(nkn + kon[1]); kR = LDU(nkr + kor); }
    M4_E(cb, 0); SBAR();
    oa1 = MF32(vf[2], xa0, oa1); M4_E(cb, 1); M4_F(cb, 0, sb0, sb1, pb0, pb1); SBAR();
    oa0 = MF32(vf[1], xa1, oa0); M4_F(cb, 1, sb0, sb1, pb0, pb1); M4_E(cb, 2); SBAR();
    oa1 = MF32(vf[3], xa1, oa1); M4_E(cb, 3); SBAR();
    const bf16x8 xb0 = __builtin_bit_cast(bf16x8, pb0);
    ob0 = MF32(vf[0], xb0, ob0); M4_F(cb, 2, sb0, sb1, pb0, pb1); SBAR();
    ob1 = MF32(vf[2], xb0, ob1); M4_F(cb, 3, sb0, sb1, pb0, pb1); SBAR();
    const bf16x8 xb1 = __builtin_bit_cast(bf16x8, pb1);
    ob0 = MF32(vf[1], xb1, ob0); SBAR();
    ob1 = MF32(vf[3], xb1, ob1); la += sa0 + sa1; lb += sb0 + sb1; SBAR();
    if (HAS_NEXT && track) {
#pragma unroll
        for (int r = 0; r < 16; ++r) { na[r] -= ma; nb[r] -= mb; }
        float ta, tb; M2_MAX_A(na, ta); M2_MAX_B(na, ta); M2_MAX_A(nb, tb); M2_MAX_B(nb, tb);
        if (__any(ta > MLA_THRL || tb > MLA_THRL)) {
            const float da = fmaxf(ta, 0.f), db_ = fmaxf(tb, 0.f), fa = __builtin_amdgcn_exp2f(-da), fb = __builtin_amdgcn_exp2f(-db_);
            ma += da; mb += db_; la *= fa; lb *= fb;
#pragma unroll
            for (int r = 0; r < 16; ++r) { na[r] -= da; nb[r] -= db_; oa0[r] *= fa; oa1[r] *= fa; ob0[r] *= fb; ob1[r] *= fb; }
        }
    }
}
__device__ __forceinline__ void mla8_unit(LAS unsigned char* lds, const unsigned char* Qr8u  , const unsigned char* Q8u  , const MlaSrc cs,
                                          float kn_bound, float kr_bound, bf16_t* Ou, float* ssqu) {
    constexpr int NT = S / 64;
    const int tid = opaque((int)threadIdx.x), lane = tid & 63, r32 = lane & 31, hi = lane >> 5, wv = __builtin_amdgcn_readfirstlane(tid >> 6);
    long qar[2], qbr[2]; u32x4 qna[2], qnb[2], qra, qrb;
#pragma unroll
    for (int g = 0; g < 2; ++g) { qna[g] = *(const u32x4*)(Q8u + (size_t)(64 * wv + r32) * 512 + 32 * hi + 16 * g); qnb[g] = *(const u32x4*)(Q8u + (size_t)(64 * wv + 32 + r32) * 512 + 32 * hi + 16 * g); }
    const i32x8 qa8 = CAT8(qna[0], qna[1]), qb8 = CAT8(qnb[0], qnb[1]);
    qra = *(const u32x4*)(Qr8u + (size_t)(64 * wv + r32) * 256 + 16 * hi); qrb = *(const u32x4*)(Qr8u + (size_t)(64 * wv + 32 + r32) * 256 + 16 * hi);
#pragma unroll
    for (int j = 0; j < 2; ++j) { qar[j] = PK64(qra[2 * j], qra[2 * j + 1]); qbr[j] = PK64(qrb[2 * j], qrb[2 * j + 1]); }
    MlaDma dm; dm.wv = wv;
    { const int row = 8 * wv + (lane >> 3), lg = (lane & 7) ^ ((row >> 1) & 7); dm.ko = row * 64 + lg * 8;
      const int rr = 16 * wv + (lane >> 2), lr = (lane & 3) ^ ((rr >> 2) & 3); dm.ro = rr * 32 + lr * 8;
      const int r8 = 32 * (wv & 1) + (lane >> 1); dm.r8 = r8 * 32 + (((lane & 1) ^ ((r8 >> 3) & 1)) << 4); }
    const int pr = (r32 & ~12) | ((r32 & 4) << 1) | ((r32 & 8) >> 1);
    int kon[2], kor, vo0[2], vo1[2];
#pragma unroll
    for (int g = 0; g < 2; ++g) kon[g] = pr * 64 + (((2 * hi + g) ^ ((pr >> 2) & 3)) << 4);
    kor = AT3_KR + pr * 32 + ((hi ^ ((pr >> 3) & 1)) << 4);
#pragma unroll
    for (int s = 0; s < 2; ++s) { vo0[s] = AT3_VT + r32 * 128 + (((2 * s + hi) ^ ((r32 >> 1) & 7)) << 4); vo1[s] = AT3_VT + r32 * 128 + (((4 + 2 * s + hi) ^ ((r32 >> 1) & 7)) << 4); }
    __syncthreads();
    mla_dma8(dm, cs, lds, 0); mla_dma8(dm, cs, lds + AT3_BUF, 1);
    asm volatile("s_waitcnt vmcnt(0)" ::: "memory");
    __syncthreads();
    bool fast;
    { float an2 = 0.f, ar2 = 0.f, bn2 = 0.f, br2 = 0.f;
#pragma unroll
      for (int g = 0; g < 2; ++g)
#pragma unroll
          for (int e = 0; e < 4; ++e) {
              const int wa = (int)qna[g][e], wb = (int)qnb[g][e];
              const float a0 = __builtin_amdgcn_cvt_f32_fp8(wa, 0), a1 = __builtin_amdgcn_cvt_f32_fp8(wa, 1), a2 = __builtin_amdgcn_cvt_f32_fp8(wa, 2), a3 = __builtin_amdgcn_cvt_f32_fp8(wa, 3);
              const float b0 = __builtin_amdgcn_cvt_f32_fp8(wb, 0), b1 = __builtin_amdgcn_cvt_f32_fp8(wb, 1), b2 = __builtin_amdgcn_cvt_f32_fp8(wb, 2), b3 = __builtin_amdgcn_cvt_f32_fp8(wb, 3);
              an2 += (a0 * a0 + a1 * a1) + (a2 * a2 + a3 * a3); bn2 += (b0 * b0 + b1 * b1) + (b2 * b2 + b3 * b3); }
#pragma unroll
      for (int e = 0; e < 4; ++e) {
          const int wa = (int)qra[e], wb = (int)qrb[e];
          const float a0 = __builtin_amdgcn_cvt_f32_fp8(wa, 0), a1 = __builtin_amdgcn_cvt_f32_fp8(wa, 1), a2 = __builtin_amdgcn_cvt_f32_fp8(wa, 2), a3 = __builtin_amdgcn_cvt_f32_fp8(wa, 3);
          const float b0 = __builtin_amdgcn_cvt_f32_fp8(wb, 0), b1 = __builtin_amdgcn_cvt_f32_fp8(wb, 1), b2 = __builtin_amdgcn_cvt_f32_fp8(wb, 2), b3 = __builtin_amdgcn_cvt_f32_fp8(wb, 3);
          ar2 += (a0 * a0 + a1 * a1) + (a2 * a2 + a3 * a3); br2 += (b0 * b0 + b1 * b1) + (b2 * b2 + b3 * b3); }
      an2 += __shfl_xor(an2, 32); ar2 += __shfl_xor(ar2, 32); bn2 += __shfl_xor(bn2, 32); br2 += __shfl_xor(br2, 32);
      const float ba = (sqrtf(an2) * kn_bound + sqrtf(ar2) * kr_bound) * (1.15f / Q8_PRE), bb = (sqrtf(bn2) * kn_bound + sqrtf(br2) * kr_bound) * (1.15f / Q8_PRE);
      fast = __all(ba < 64.0f && bb < 64.0f); }
    f32x16 pA0, pA1, pB0, pB1, oa0, oa1, ob0, ob1;
#pragma unroll
    for (int r = 0; r < 16; ++r) { pA0[r] = 0.f; pA1[r] = 0.f; oa0[r] = 0.f; oa1[r] = 0.f; ob0[r] = 0.f; ob1[r] = 0.f; }
    float ma = 0.f, mb = 0.f, la = 0.f, lb = 0.f;
    {
        { u32x4 kN[2]; kN[0] = LDU(lds + kon[0]); kN[1] = LDU(lds + kon[1]);
          { const i32x8 k8 = CAT8(kN[0], kN[1]); pA0 = MFS(k8, qa8, pA0); pA1 = MFS(k8, qb8, pA1); }
          { const u32x4 kR = LDU(lds + kor);
#pragma unroll
            for (int j = 0; j < 2; ++j) { pA0 = MF8(KR8(j), qar[j], pA0); pA1 = MF8(KR8(j), qbr[j], pA1); } } }
        if (!fast) {
            float ta, tb; M2_MAX_A(pA0, ta); M2_MAX_B(pA0, ta); M2_MAX_A(pA1, tb); M2_MAX_B(pA1, tb); ma = ta; mb = tb;
#pragma unroll
            for (int r = 0; r < 16; ++r) { pA0[r] -= ma; pA1[r] -= mb; }
        }
    }
    u32x4 kN[2], kR;
    kN[0] = LDU(lds + 2048 + kon[0]); kN[1] = LDU(lds + 2048 + kon[1]); kR = LDU(lds + 1024 + kor);
#define M6_ARGS(A0, A1, B0, B1) A0, A1, B0, B1, oa0, oa1, ob0, ob1, ma, mb, la, lb, qa8, qb8, qar, qbr, kN, kR
#define M6_TILE(B, N, W, DO, TD) do { \
        mla8_step<true, true, true>(M6_ARGS(pA0, pA1, pB0, pB1), BUF3(B), BUF3(N), BUF3(N), kon, kor, vo0, dm, cs, BUF3(W), DO, TD, !fast); \
        mla8_step<true, true, false>(M6_ARGS(pB0, pB1, pA0, pA1), BUF3(B), BUF3(N) + 2048, BUF3(N) + 1024, kon, kor, vo1, dm, cs, BUF3(W), false, 0, !fast); } while (0)
#pragma nounroll
    for (int t = 0; t < NT - 1; t += 3) {
        M6_TILE(0, 1, 2, true, t + 2);
        M6_TILE(1, 2, 0, true, t + 3);
        M6_TILE(2, 0, 1, t + 4 < NT, t + 4);
    }
    mla8_step<true, false, true>(M6_ARGS(pA0, pA1, pB0, pB1), BUF3(0), BUF3(1), BUF3(1), kon, kor, vo0, dm, cs, BUF3(2), false, 0, !fast);
    mla8_step<false, false, false>(M6_ARGS(pB0, pB1, pA0, pA1), BUF3(0), BUF3(1), BUF3(1), kon, kor, vo1, dm, cs, BUF3(2), false, 0, !fast);
    la += __shfl_xor(la, 32); lb += __shfl_xor(lb, 32);
    const int lane_m = opaque((int)threadIdx.x) & 63, r32m = lane_m & 31, him = lane_m >> 5;
#pragma unroll
    for (int blk = 0; blk < 2; ++blk) {
        f32x16& o0 = blk ? ob0 : oa0; f32x16& o1 = blk ? ob1 : oa1; const float inv = 1.0f / (blk ? lb : la);
        float qs = 0.f;
#pragma unroll
        for (int r = 0; r < 16; ++r) { o0[r] *= inv; o1[r] *= inv; qs += o0[r] * o0[r] + o1[r] * o1[r]; }
        qs += __shfl_xor(qs, 32);
        if (him == 0) atomicAdd(ssqu + 64 * wv + 32 * blk + r32m, qs);
        bf16_t* orow = Ou + (size_t)(64 * wv + 32 * blk + r32m) * D + 4 * him;
#pragma unroll
        for (int g = 0; g < 4; ++g) {
            u32x2 w0, w1;
            w0.x = cvt_pk_bf16(o0[4 * g], o0[4 * g + 1]); w0.y = cvt_pk_bf16(o0[4 * g + 2], o0[4 * g + 3]); w1.x = cvt_pk_bf16(o1[4 * g], o1[4 * g + 1]); w1.y = cvt_pk_bf16(o1[4 * g + 2], o1[4 * g + 3]);
            *(u32x2*)(orow + 8 * g) = w0; *(u32x2*)(orow + 32 + 8 * g) = w1;
        }
    }
}

constexpr int WN_TILE = 16384, WN_VT = 8192;
template <bool MASK>
__device__ __forceinline__ void win_tile(const LAS unsigned char* tb, const int (&kon)[4], const int (&vo)[4], const bf16x8 (&q)[4], f32x16& o0, f32x16& o1, float& mrun, float& lrun, int dj) {
    f32x16 p0, p1;
#pragma unroll
    for (int r = 0; r < 16; ++r) { p0[r] = 0.f; p1[r] = 0.f; }
#pragma unroll
    for (int d0 = 0; d0 < 4; ++d0) { p0 = MF32(LDF(tb + kon[d0]), q[d0], p0); p1 = MF32(LDF(tb + kon[d0] + 4096), q[d0], p1); }
    if (MASK) {
#pragma unroll
        for (int r = 0; r < 16; ++r) { const int d = dj + (r & 7) + 16 * (r >> 3);
            if (d < -128 || d > 128) p0[r] = -INFINITY;
            if (d + 32 < -128 || d + 32 > 128) p1[r] = -INFINITY; }
    }
    float tm = max3f(p0[0], p1[0], p0[1]);
#pragma unroll
    for (int r = 1; r < 15; r += 2) { tm = max3f(tm, p1[r], p0[r + 1]); tm = max3f(tm, p1[r + 1], p0[r + 2 > 15 ? 15 : r + 2]); }
    tm = fmaxf(tm, p1[15]);
    tm = xhalf_max(tm);
    const float mn = fmaxf(mrun, tm), alpha = __builtin_amdgcn_exp2f(mrun - mn);
    mrun = mn;
    float rs = 0.f;
#pragma unroll
    for (int r = 0; r < 16; ++r) { p0[r] = __builtin_amdgcn_exp2f(p0[r] - mn); p1[r] = __builtin_amdgcn_exp2f(p1[r] - mn); rs += p0[r] + p1[r]; }
    lrun = lrun * alpha + rs;
#pragma unroll
    for (int r = 0; r < 16; ++r) { o0[r] *= alpha; o1[r] *= alpha; }
#pragma unroll
    for (int s = 0; s < 2; ++s) {
        u32x4 w0, w1;
        w0.x = cvt_pk_bf16(p0[8 * s + 0], p0[8 * s + 1]); w0.y = cvt_pk_bf16(p0[8 * s + 2], p0[8 * s + 3]); w0.z = cvt_pk_bf16(p0[8 * s + 4], p0[8 * s + 5]); w0.w = cvt_pk_bf16(p0[8 * s + 6], p0[8 * s + 7]);
        w1.x = cvt_pk_bf16(p1[8 * s + 0], p1[8 * s + 1]); w1.y = cvt_pk_bf16(p1[8 * s + 2], p1[8 * s + 3]); w1.z = cvt_pk_bf16(p1[8 * s + 4], p1[8 * s + 5]); w1.w = cvt_pk_bf16(p1[8 * s + 6], p1[8 * s + 7]);
        const bf16x8 b0 = __builtin_bit_cast(bf16x8, w0), b1 = __builtin_bit_cast(bf16x8, w1);
        o0 = MF32(LDF(tb + WN_VT + vo[s]), b0, o0); o1 = MF32(LDF(tb + WN_VT + vo[s] + 4096), b0, o1);
        o0 = MF32(LDF(tb + WN_VT + vo[2 + s]), b1, o0); o1 = MF32(LDF(tb + WN_VT + vo[2 + s] + 4096), b1, o1);
    }
}
__device__ __forceinline__ void win_phase(LAS unsigned char* lds, int vcu, int G, const bf16_t* Qa, const bf16_t* Ka, const bf16_t* VaT, const float* sink, bf16_t* attn_out, float* ssq_a) {
    const int tid = threadIdx.x, lane = tid & 63, r32 = lane & 31, hi = lane >> 5, wv = __builtin_amdgcn_readfirstlane(tid >> 6), hh = wv & 3, sub = wv >> 2;
    const int pr = (r32 & ~12) | ((r32 & 4) << 1) | ((r32 & 8) >> 1);
    int kon[4], vo[4];
#pragma unroll
    for (int d0 = 0; d0 < 4; ++d0) kon[d0] = pr * 128 + (((2 * d0 + hi) ^ ((pr >> 1) & 7)) << 4);
#pragma unroll
    for (int k = 0; k < 4; ++k) vo[k] = r32 * 128 + (((2 * k + hi) ^ ((r32 >> 1) & 7)) << 4);
    const int drow = 8 * wv + (lane >> 3), dlg = (lane & 7) ^ ((drow >> 1) & 7), dsrc = drow * 64 + dlg * 8;
    for (int su = vcu; su < 256; su += G) {
        const int bk = su >> 6, b = bk >> 1, kvh = bk & 1, j0 = (su & 63) * 4;
        const bf16_t* Kt = Ka + (size_t)bk * S * 64; const bf16_t* Vt = VaT + (size_t)bk * S * 64;
        __syncthreads();
#pragma unroll
        for (int i = 0; i < 8; ++i) { const int tile = j0 - 2 + i;
            if (tile >= 0 && tile < S / 64) {
                __builtin_amdgcn_global_load_lds((const unsigned*)(Kt + (size_t)tile * 4096 + dsrc), (LAS unsigned*)(lds + i * WN_TILE + wv * 1024), 16, 0, 0);
                __builtin_amdgcn_global_load_lds((const unsigned*)(Vt + (size_t)tile * 4096 + dsrc), (LAS unsigned*)(lds + i * WN_TILE + WN_VT + wv * 1024), 16, 0, 0);
            } }
        asm volatile("s_waitcnt vmcnt(0)" ::: "memory");
        __syncthreads();
        const int hd = kvh * 4 + hh; const float sink_l2 = sink[hd] * LOG2E;
        for (int u = 0; u < 4; ++u) {
            const int j = j0 + u, qw = 64 * j + 32 * sub;
            const bf16_t* Qw = Qa + ((size_t)b * S + qw) * 512 + hd * 64;
            bf16x8 q[4];
#pragma unroll
            for (int d0 = 0; d0 < 4; ++d0) q[d0] = *(const bf16x8*)(Qw + (size_t)r32 * 512 + d0 * 16 + hi * 8);
            float mrun = -1e30f, lrun = 0.f; f32x16 o0, o1;
#pragma unroll
            for (int r = 0; r < 16; ++r) { o0[r] = 0.f; o1[r] = 0.f; }
#pragma unroll
            for (int rel = -2; rel <= 2; ++rel) { const int tile = j + rel;
                if (tile >= 0 && tile < S / 64) { const LAS unsigned char* tb = lds + (u + rel + 2) * WN_TILE; const int dj = tile * 64 + 8 * hi - (qw + r32);
                    if (rel == -2 || rel == 2) win_tile<true>(tb, kon, vo, q, o0, o1, mrun, lrun, dj); else win_tile<false>(tb, kon, vo, q, o0, o1, mrun, lrun, dj); } }
            float ltot = lrun + __shfl_xor(lrun, 32);
            { const float mf = fmaxf(mrun, sink_l2), a = __builtin_amdgcn_exp2f(mrun - mf); ltot = ltot * a + __builtin_amdgcn_exp2f(sink_l2 - mf);
              const float inv = a / ltot; float qs = 0.f;
#pragma unroll
              for (int r = 0; r < 16; ++r) { o0[r] *= inv; o1[r] *= inv; qs += o0[r] * o0[r] + o1[r] * o1[r]; }
              qs += __shfl_xor(qs, 32);
              if (hi == 0) atomicAdd(ssq_a + (size_t)b * S + qw + r32, qs); }
            bf16_t* orow = attn_out + ((size_t)b * S + qw + r32) * D + hd * 64 + 4 * hi;
#pragma unroll
            for (int g = 0; g < 4; ++g) {
                u32x2 w0, w1; w0.x = cvt_pk_bf16(o0[4 * g], o0[4 * g + 1]); w0.y = cvt_pk_bf16(o0[4 * g + 2], o0[4 * g + 3]); w1.x = cvt_pk_bf16(o1[4 * g], o1[4 * g + 1]); w1.y = cvt_pk_bf16(o1[4 * g + 2], o1[4 * g + 3]);
                *(u32x2*)(orow + 8 * g) = w0; *(u32x2*)(orow + 32 + 8 * g) = w1;
            }
        }
    }
}

struct Args { const float* in[24]; const int* pos; float* out; unsigned char* ws; int ph_lo, ph_hi; };

struct ConvDesc { const float* colptr; size_t ldw; const float* ga; const float* gb; int gsplit, k0, K; bf16_t* dst; };
__device__ __forceinline__ void conv_load(const ConvDesc& d, float (&v)[32], int lane) {
#pragma unroll
    for (int i = 0; i < 32; ++i) { const int k = d.k0 + 2 * i + (lane >> 5); v[i] = d.colptr ? d.colptr[(size_t)k * d.ldw] : 0.f; }
}
__device__ __forceinline__ void conv_store(const ConvDesc& d, float (&v)[32], LAS float* scr, int lane) {
    if (d.ga) {
#pragma unroll
        for (int i = 0; i < 32; ++i) { const int k = d.k0 + 2 * i + (lane >> 5); v[i] *= (k < d.gsplit ? d.ga[k] : d.gb[k - d.gsplit]); }
    }
#pragma unroll
    for (int i = 0; i < 32; ++i) scr[(2 * i + (lane >> 5)) * 33 + (lane & 31)] = v[i];
    asm volatile("s_waitcnt lgkmcnt(0)" ::: "memory");
    const int c = lane & 7;
#pragma unroll
    for (int j = 0; j < 4; ++j) { const int n = (lane >> 3) + 8 * j; const LAS float* s = scr + (8 * c) * 33 + n;
        u32x4 o; o.x = cvt_pk_bf16(s[0 * 33], s[1 * 33]); o.y = cvt_pk_bf16(s[2 * 33], s[3 * 33]); o.z = cvt_pk_bf16(s[4 * 33], s[5 * 33]); o.w = cvt_pk_bf16(s[6 * 33], s[7 * 33]);
        *(u32x4*)(d.dst + (size_t)n * d.K + d.k0 + 8 * c) = o; }
    asm volatile("s_waitcnt lgkmcnt(0)" ::: "memory");
}
__device__ __forceinline__ int pairperm(int p, int half) {
    const int a = p >> 3, b = p & 7; return b < 4 ? 4 * a + b : half + 4 * a + (b - 4);
}

__global__ void __launch_bounds__(NWAVES * 64, 2) fwd_kernel(Args args) {
    extern __shared__ __attribute__((aligned(16))) unsigned char lds_raw[];
    LAS unsigned char* lds = (LAS unsigned char*)lds_raw;
    volatile LAS unsigned* MISC = (volatile LAS unsigned*)(lds + MISC_OFF);
    const int tid = threadIdx.x, lane = tid & 63, wave = __builtin_amdgcn_readfirstlane(tid >> 6);
    const int G = gridDim.x; const int bx = blockIdx.x; const int vcu = (G % 8 == 0) ? (bx % 8) * (G / 8) + bx / 8 : bx;
    unsigned char* ws = args.ws;
    unsigned* ctl = (unsigned*)(ws + WS_CTL);
    float* ctlf = (float*)(ws + WS_CTL);
    for (int u = tid; u < (LDS_BYTES - MISC_OFF) / 4; u += NWAVES * 64) ((LAS unsigned*)(lds + MISC_OFF))[u] = 0u;
    __syncthreads();
    XcdBarrier bar; bar.bar = ctl + CW_BAR; bar.x = 0; bar.st = nullptr;
    if (N_LAUNCHES == 1) bar = xcd_barrier_post(ctl + CW_BAR, MISC + 8);
    const int lo = args.ph_lo, hi_ph = args.ph_hi;
#ifndef PHMASK
#define PHMASK 0x1ff
#endif
#define IN(k) (((PHMASK >> (k)) & 1) && lo <= (k) && (k) < hi_ph)
#define SEAM(k) do { if (IN(k) && IN((k) + 1)) xcd_barrier(bar); } while (0)
    const int gw = vcu * NWAVES + wave, NGW = G * NWAVES;

    const float* x = args.in[0];
    bf16_t* W1t = (bf16_t*)(ws + WS_W1T); bf16_t* W2q = (bf16_t*)(ws + WS_W2Q); bf16_t* W2kv = (bf16_t*)(ws + WS_W2KV); bf16_t* W4t = (bf16_t*)(ws + WS_W4T);
    bf16_t* Wgu = (bf16_t*)(ws + WS_WGU); bf16_t* Wd = (bf16_t*)(ws + WS_WD); bf16_t* Wrt = (bf16_t*)(ws + WS_WRT);
    float* cosA = (float*)(ws + WS_COSA); float* sinA = (float*)(ws + WS_SINA); float* cosB = (float*)(ws + WS_COSB); float* sinB = (float*)(ws + WS_SINB);
    float* xstat = (float*)(ws + WS_XSTAT);
    bf16_t* h0b = (bf16_t*)(ws + WS_H0B); bf16_t* attn_out = (bf16_t*)(ws + WS_H0B); bf16_t* h1b = (bf16_t*)(ws + WS_H0B);
    bf16_t* cq = (bf16_t*)(ws + WS_CQ); bf16_t* hid = (bf16_t*)(ws + WS_CQ); bf16_t* ckv = (bf16_t*)(ws + WS_CKV);
    bf16_t* Qa = (bf16_t*)(ws + WS_QA); bf16_t* Ka = (bf16_t*)(ws + WS_KA); bf16_t* VaT = (bf16_t*)(ws + WS_VAT); bf16_t* Kr = (bf16_t*)(ws + WS_KR);
    bf16_t* Qb = (bf16_t*)(ws + WS_QB); bf16_t* Kn = (bf16_t*)(ws + WS_KN); bf16_t* VbT = (bf16_t*)(ws + WS_VBT); unsigned char* Qn8 = ws + WS_KN + 16 * MiB;
    bf16_t* h1pre = (bf16_t*)(ws + WS_H1PRE); bf16_t* ysl = (bf16_t*)(ws + WS_Y);
    unsigned* ltok = (unsigned*)(ws + WS_LTOK); float* lw = (float*)(ws + WS_LW);
    float* ssq_q = ctlf + CW_SSQ_Q; float* ssq_kv = ctlf + CW_SSQ_KV; float* ssq_a = ctlf + CW_SSQ_A; float* ssq_b = ctlf + CW_SSQ_B; float* s1 = ctlf + CW_S1; float* s2 = ctlf + CW_S2;

    constexpr int I0 = 16 * 64, I1 = 12 * 24, I2 = 4 * 32, I3 = 16 * 32, I4 = 32 * 256, I5 = 32 * 128, I6 = 16 * 2;
    constexpr int NITEMS = I0 + I1 + I2 + I3 + I4 + I5 + I6;
    const int nn = lane & 31;
    auto decode = [&](int r, ConvDesc& d) {
        d.ga = nullptr; d.gb = nullptr; d.gsplit = 0;
        if (r < I0) {
            const int kb = r / 64, nb = r % 64, n = nb * 32 + nn; int src;
            if (n < 640) src = (n & ~63) + pairperm(n & 63, 32); else if (n < 1792) src = n; else if (n < 1824) src = 1792 + pairperm(n - 1792, 16); else src = -1;
            d.colptr = src >= 0 ? args.in[4] + src : nullptr; d.ldw = IN_COLS; d.k0 = kb * 64; d.K = 1024; d.dst = W1t + (size_t)(nb * 32) * 1024; return; } r -= I0;
        if (r < I1) {
            const int kb = r / 24, nb = r % 24, n = nb * 32 + nn; int src;
            if (n < 512) src = (n >> 6) * 96 + (n & 63); else { const int hd = (n - 512) >> 5, p = (n - 512) & 31; src = hd * 96 + 64 + pairperm(p, 16); }
            d.colptr = args.in[7] + src; d.ldw = 768; d.ga = args.in[6]; d.gb = args.in[6]; d.gsplit = 1 << 30; d.k0 = kb * 64; d.K = 768; d.dst = W2q + (size_t)(nb * 32) * 768; return; } r -= I1;
        if (r < I2) {
            const int kb = r / 32, nb = r % 32, n = nb * 32 + nn; const int src = (n < 512) ? (n >> 6) * 128 + (n & 63) : ((n - 512) >> 6) * 128 + 64 + (n & 63);
            d.colptr = args.in[9] + src; d.ldw = 1024; d.ga = args.in[8]; d.gb = args.in[8]; d.gsplit = 1 << 30; d.k0 = kb * 64; d.K = 256; d.dst = W2kv + (size_t)(nb * 32) * 256; return; } r -= I2;
        if (r < I3) {
            const int kb = r / 32, nb = r % 32, n = nb * 32 + nn;
            d.colptr = args.in[12] + n; d.ldw = 1024; d.ga = args.in[10]; d.gb = args.in[11]; d.gsplit = 512; d.k0 = kb * 64; d.K = 1024; d.dst = W4t + (size_t)(nb * 32) * 1024; return; } r -= I3;
        if (r < I4) {
            const int e = r / 256, r2 = r % 256, kb = r2 / 16, nb = r2 % 16, n = nb * 32 + nn, qq = n >> 8, j = n & 255;
            d.colptr = (j < 128) ? args.in[19] + (size_t)e * 1024 * 256 + 128 * qq + j : args.in[20] + (size_t)e * 1024 * 256 + 128 * qq + (j - 128);
            d.ldw = 256; d.k0 = kb * 64; d.K = 1024; d.dst = Wgu + ((size_t)e * 512 + nb * 32) * 1024; return; } r -= I4;
        if (r < I5) {
            const int e = r / 128, r2 = r % 128, kb = r2 / 32, nb = r2 % 32, n = nb * 32 + nn;
            d.colptr = args.in[21] + (size_t)e * 256 * 1024 + n; d.ldw = 1024; d.k0 = kb * 64; d.K = 256; d.dst = Wd + ((size_t)e * 1024 + nb * 32) * 256; return; } r -= I5;
        {
            const int kb = r / 2, nb = r % 2, n = nb * 32 + nn;
            d.colptr = (n < 4) ? args.in[15] + n : (n < 36) ? args.in[17] + (n - 4) : nullptr; d.ldw = (n < 4) ? 4 : 32; d.k0 = kb * 64; d.K = 1024; d.dst = Wrt + (size_t)(nb * 32) * 1024;
        }
    };
#define CONV_RUN(n_, w_, nw_, MAP, scrp) do { ConvDesc dA, dB; float vA[32], vB[32]; int it = (w_); \
        if (it < (n_)) { decode(MAP(it), dA); conv_load(dA, vA, lane); } \
        while (it < (n_)) { const int itB = it + (nw_); \
            if (itB < (n_)) { decode(MAP(itB), dB); conv_load(dB, vB, lane); } \
            conv_store(dA, vA, (scrp), lane); \
            if (itB >= (n_)) break; \
            const int itA = itB + (nw_); \
            if (itA < (n_)) { decode(MAP(itA), dA); conv_load(dA, vA, lane); } \
            conv_store(dB, vB, (scrp), lane); \
            it = itA; } } while (0)
#define CONV_MAP_P0(i) ((i) < I0 + I1 + I2 + I3 ? (i) : (i) + I4 + I5)
#define CONV_MAP_MOE(i) ((i) + I0 + I1 + I2 + I3)
    if (IN(0)) {
        LAS float* scr = (LAS float*)(lds + wave * 16384);
        CONV_RUN(I0 + I1 + I2 + I3 + I6, gw, NGW, CONV_MAP_P0, scr);
        {
            const int j = lane & 31; const float inv = 1.0f / powf(10000.0f, (float)(2 * j) / 64.0f);
            for (int i = gw * 64 + lane; i < T * 32; i += NGW * 64) {
                const int tok = i >> 5; const float ang = (float)args.pos[tok] * inv;
                const double rev = (double)ang * 0.15915494309189535; const float fr = (float)(rev - rint(rev));
                const float cs = __builtin_amdgcn_cosf(fr), sn = __builtin_amdgcn_sinf(fr);
                cosA[(size_t)tok * 32 + j] = cs; sinA[(size_t)tok * 32 + j] = sn;
                if ((j & 1) == 0) { cosB[(size_t)tok * 16 + (j >> 1)] = cs; sinB[(size_t)tok * 16 + (j >> 1)] = sn; }
            }
        }
        {
            f32x4 g[4], bb[4];
#pragma unroll
            for (int j = 0; j < 4; ++j) { g[j] = *(const f32x4*)(args.in[2] + 4 * lane + 256 * j); bb[j] = *(const f32x4*)(args.in[3] + 4 * lane + 256 * j); }
            for (int row0 = gw * 4; row0 < T; row0 += NGW * 4) {
                f32x4 v[4][4]; float s[4], q[4];
#pragma unroll
                for (int r = 0; r < 4; ++r) { const f32x4* xr = (const f32x4*)(x + (size_t)(row0 + r) * D) + lane;
#pragma unroll
                    for (int j = 0; j < 4; ++j) v[r][j] = xr[64 * j]; }
#pragma unroll
                for (int r = 0; r < 4; ++r) { s[r] = 0.f;
#pragma unroll
                    for (int j = 0; j < 4; ++j) s[r] += (v[r][j][0] + v[r][j][1]) + (v[r][j][2] + v[r][j][3]); }
#pragma unroll
                for (int o = 1; o < 64; o <<= 1) {
#pragma unroll
                    for (int r = 0; r < 4; ++r) s[r] += __shfl_xor(s[r], o); }
#pragma unroll
                for (int r = 0; r < 4; ++r) { s[r] *= (1.f / D); q[r] = 0.f;
#pragma unroll
                    for (int j = 0; j < 4; ++j) { v[r][j] = v[r][j] - s[r]; q[r] += sq4(v[r][j]); } }
#pragma unroll
                for (int o = 1; o < 64; o <<= 1) {
#pragma unroll
                    for (int r = 0; r < 4; ++r) q[r] += __shfl_xor(q[r], o); }
#pragma unroll
                for (int r = 0; r < 4; ++r) { const float rstd = fast_rsqrt(q[r] * (1.f / D) + LN_EPS);
                    u32x2* o8 = (u32x2*)(h0b + (size_t)(row0 + r) * D) + lane;
#pragma unroll
                    for (int j = 0; j < 4; ++j) { const f32x4 y = v[r][j] * rstd * g[j] + bb[j]; u32x2 w; w.x = cvt_pk_bf16(y[0], y[1]); w.y = cvt_pk_bf16(y[2], y[3]); o8[64 * j] = w; }
                    if (lane == 0) { xstat[2 * (row0 + r)] = s[r]; xstat[2 * (row0 + r) + 1] = rstd; } }
            }
        }
    }
    SEAM(0);
    if (IN(1)) {
        pg8::DenseSched<D> Sd; Sd.init(h0b, W1t, T, N1, G, bx);
        Epi1 E{Qa, Ka, VaT, cq, ckv, Kr, ssq_q, ssq_kv, cosA, sinA, cosB, sinB, ctl + CW_KR2};
        pg8::gemm_phase<Epi1, pg8::DenseSched<D>, true, D>(lds, Sd, E);
    }
    SEAM(1);
    if (IN(2)) {
        { pg8::DenseSched<768> Sd; Sd.init(cq, W2q, T, 768, G, bx); Epi2q E{Qb, Qn8, ssq_q, cosB, sinB}; pg8::gemm_phase<Epi2q, pg8::DenseSched<768>, true, 768>(lds, Sd, E); }
        __syncthreads();
        { pg8::DenseSched<256> Sd; Sd.init(ckv, W2kv, T, 1024, G, bx); Epi2kv E{Kn, VbT, ssq_kv, ctl + CW_KN2}; pg8::gemm_phase<Epi2kv, pg8::DenseSched<256>, true, 256>(lds, Sd, E); }
    }
    SEAM(2);
    if (IN(3)) {
        for (int u = vcu; u < 512; u += G) {
            const int bh = u >> 5, b = bh >> 3, hd = bh & 7, q0 = (u & 31) * 512;
            const MlaSrc cs{(const bf16_t*)((const unsigned char*)Kn + (size_t)bh * S * 64), (const bf16_t*)((const unsigned char*)Kr + (size_t)b * S * 32), VbT + (size_t)bh * S * 64};
            const float kn_bound = sqrtf(__uint_as_float(ctl[CW_KN2 + bh * 2]) + __uint_as_float(ctl[CW_KN2 + bh * 2 + 1])) * 1.01f, kr_bound = sqrtf(__uint_as_float(ctl[CW_KR2 + b])) * 1.01f;
            mla8_unit(lds, (const unsigned char*)Qb + ((size_t)b * S + q0) * 256 + hd * 32, Qn8 + ((size_t)b * S + q0) * 512 + hd * 64, cs, kn_bound, kr_bound, attn_out + ((size_t)b * S + q0) * D + 512 + hd * 64, ssq_b + (size_t)b * S + q0);
        }
        win_phase(lds, vcu, G, Qa, Ka, VaT, args.in[5], attn_out, ssq_a);
        __syncthreads();
    }
    SEAM(3);
    if (IN(4)) {
        pg8::DenseSched<D> Sd; Sd.init(attn_out, W4t, T, D, G, bx);
        Epi4 E{x, xstat, args.in[2], args.in[3], ssq_a, ssq_b, h1pre, s1, s2};
        pg8::gemm_phase<Epi4, pg8::DenseSched<D>, true, D>(lds, Sd, E);
    }
    SEAM(4);
    if (IN(5)) {
        LAS unsigned char* wl = lds + wave * 16896;
        constexpr int NCV_HI = (I4 + I5) / 3 * 2;
        if (wave >= 4) { CONV_RUN(NCV_HI, (wave - 4) * G + vcu, 4 * G, CONV_MAP_MOE, (LAS float*)wl); }
        const int r32 = lane & 31, hi = lane >> 5;
        for (int grp = wave * G + vcu; grp < T / 32; grp += NGW) {
            const int row0 = grp * 32;
            float mu_l, rs_l;
            { const float a = s1[row0 + r32] * (1.f / D), bq = s2[row0 + r32] * (1.f / D); mu_l = a; rs_l = fast_rsqrt(fmaxf(bq - a * a, 0.f) + LN_EPS); }
            f32x16 a0, a1;
#pragma unroll
            for (int r = 0; r < 16; ++r) { a0[r] = 0.f; a1[r] = 0.f; }
            for (int c = 0; c < 4; ++c) {
                const int col = 256 * c + 4 * lane;
                const bf16_t* wb0 = Wrt + (size_t)r32 * 1024 + 256 * c + 8 * hi; const bf16_t* wb1 = wb0 + 32 * 1024;
                bf16x8 blo[16];
#pragma unroll
                for (int ks = 0; ks < 8; ++ks) { blo[2 * ks] = *(const bf16x8*)(wb0 + 16 * ks); blo[2 * ks + 1] = *(const bf16x8*)(wb1 + 16 * ks); }
                const f32x4 g = *(const f32x4*)(args.in[13] + col), bb = *(const f32x4*)(args.in[14] + col);
                __builtin_amdgcn_sched_barrier(0);
                { u32x2 hv[32];
                  const bf16_t* rp = h1pre + (size_t)row0 * D + col;
#pragma unroll
                  for (int r = 0; r < 32; ++r) hv[r] = *(const u32x2*)(rp + (size_t)r * D);
                  __builtin_amdgcn_sched_barrier(0);
                  bf16_t* wp = h1b + (size_t)row0 * D + col;
#pragma unroll
                  for (int r = 0; r < 32; ++r) {
                    const float mu = __shfl(mu_l, r), rs = __shfl(rs_l, r);
                    const f32x4 v = (f32x4){bf_lo(hv[r].x), bf_hi(hv[r].x), bf_lo(hv[r].y), bf_hi(hv[r].y)};
                    const f32x4 y = (v - mu) * rs * g + bb;
                    u32x2 w; w.x = cvt_pk_bf16(y[0], y[1]); w.y = cvt_pk_bf16(y[2], y[3]);
                    *(u32x2*)(wp + (size_t)r * D) = w;
                    *(LAS u32x2*)(wl + r * 528 + lane * 8) = w;
                  } }
                __builtin_amdgcn_sched_barrier(0);
#pragma unroll
                for (int ks = 0; ks < 8; ++ks) {
                    const bf16x8 af = *(const LAS bf16x8*)(wl + r32 * 528 + (16 * ks + 8 * hi) * 2);
                    a0 = __builtin_amdgcn_mfma_f32_32x32x16_bf16(af, blo[2 * ks], a0, 0, 0, 0);
                    a1 = __builtin_amdgcn_mfma_f32_32x32x16_bf16(af, blo[2 * ks + 1], a1, 0, 0, 0);
                }
#pragma unroll 4
                for (int ks = 8; ks < 16; ++ks) {
                    const bf16x8 af = *(const LAS bf16x8*)(wl + r32 * 528 + (16 * ks + 8 * hi) * 2);
                    const bf16x8 b0 = *(const bf16x8*)(wb0 + 16 * ks), b1 = *(const bf16x8*)(wb1 + 16 * ks);
                    a0 = __builtin_amdgcn_mfma_f32_32x32x16_bf16(af, b0, a0, 0, 0, 0);
                    a1 = __builtin_amdgcn_mfma_f32_32x32x16_bf16(af, b1, a1, 0, 0, 0);
                }
            }
            LAS float* sl = (LAS float*)wl;
#pragma unroll
            for (int r = 0; r < 16; ++r) { const int rowr = (r & 3) + 8 * (r >> 2) + 4 * hi; sl[rowr * 40 + r32] = a0[r]; if (r32 < 4) sl[rowr * 40 + 32 + r32] = a1[r]; }
            asm volatile("s_waitcnt lgkmcnt(0)" ::: "memory");
            if (lane < 32) {
                const int tok = row0 + lane; const LAS float* lr = sl + lane * 40;
                float gl[4];
#pragma unroll
                for (int j = 0; j < 4; ++j) gl[j] = lr[j] + args.in[16][j];
                int gi = 0; float gm = gl[0];
#pragma unroll
                for (int j = 1; j < 4; ++j) if (gl[j] > gm) { gm = gl[j]; gi = j; }
                float gs = 0.f;
#pragma unroll
                for (int j = 0; j < 4; ++j) gs += __expf(gl[j] - gm);
                const float pg = 1.0f / gs;
                float el[8];
#pragma unroll
                for (int j = 0; j < 8; ++j) el[j] = lr[4 + 8 * gi + j] + args.in[18][8 * gi + j];
                int i1 = 0; float v1 = el[0];
#pragma unroll
                for (int j = 1; j < 8; ++j) if (el[j] > v1) { v1 = el[j]; i1 = j; }
                int i2 = (i1 == 0) ? 1 : 0; float v2 = (i1 == 0) ? el[1] : el[0];
#pragma unroll
                for (int j = 1; j < 8; ++j) if (j != i1 && el[j] > v2) { v2 = el[j]; i2 = j; }
                const float tt = __expf(v2 - v1), w1 = pg / (1.0f + tt), w2 = pg * tt / (1.0f + tt);
                const int e1 = 8 * gi + i1, e2 = 8 * gi + i2;
                const unsigned p1 = atomicAdd(ctl + CW_ECNT + 64 * e1, 1u); ltok[(size_t)e1 * T + p1] = (unsigned)tok; lw[(size_t)e1 * T + p1] = w1;
                const unsigned p2 = atomicAdd(ctl + CW_ECNT + 64 * e2, 1u); ltok[(size_t)e2 * T + p2] = (unsigned)tok | 0x8000u; lw[(size_t)e2 * T + p2] = w2;
            }
            asm volatile("s_waitcnt lgkmcnt(0)" ::: "memory");
        }
#define CONV_MAP_MOE_LO(i) ((i) + I0 + I1 + I2 + I3 + NCV_HI)
        if (wave < 4) { CONV_RUN(I4 + I5 - NCV_HI, wave * G + vcu, 4 * G, CONV_MAP_MOE_LO, (LAS float*)wl); }
        __syncthreads();
    }
    SEAM(5);
    LAS int* tab = (LAS int*)(lds + MISC_OFF + 256);
    if (IN(6) || IN(7)) {
        if (tid < 32) { const int c = (int)__hip_atomic_load(ctl + CW_ECNT + 64 * tid, RLX_AGENT); tab[64 + tid] = c; tab[128 + tid] = (c + 255) >> 8; }
        __syncthreads();
        if (tid == 0) { int acc = 0; for (int e = 0; e < 32; ++e) { tab[e] = acc; acc += tab[128 + e]; } tab[32] = acc; }
        __syncthreads();
    }
    if (IN(6)) {
        MoeSched<0> Sm{tab, h1b, Wgu, ltok, G, bx, 2};
        EpiGU E{hid};
        pg8::gemm_phase<EpiGU, MoeSched<0>, true, D>(lds, Sm, E);
    }
    SEAM(6);
    if (IN(7)) {
        MoeSched<1> Sm{tab, hid, Wd, ltok, G, bx, 4};
        EpiD E{ltok, lw, ysl};
        pg8::gemm_phase<EpiD, MoeSched<1>, true, EFF>(lds, Sm, E);
    }
    SEAM(7);
    if (IN(8)) {
        f32x4 g1[4], b1[4], g2[4], b2[4];
#pragma unroll
        for (int j = 0; j < 4; ++j) { const int col = 4 * lane + 256 * j; g1[j] = *(const f32x4*)(args.in[13] + col); b1[j] = *(const f32x4*)(args.in[14] + col); g2[j] = *(const f32x4*)(args.in[22] + col); b2[j] = *(const f32x4*)(args.in[23] + col); }
        for (int row = gw; row < T; row += NGW) {
            const float mu1 = s1[row] * (1.f / D), rs1 = fast_rsqrt(fmaxf(s2[row] * (1.f / D) - mu1 * mu1, 0.f) + LN_EPS);
            f32x4 v[4]; float s = 0.f;
#pragma unroll
            for (int j = 0; j < 4; ++j) { const int col = 4 * lane + 256 * j;
                const u32x2 hv = *(const u32x2*)(h1pre + (size_t)row * D + col); const f32x4 hp = (f32x4){bf_lo(hv.x), bf_hi(hv.x), bf_lo(hv.y), bf_hi(hv.y)};
                const u32x2 ya = *(const u32x2*)(ysl + (size_t)row * D + col), yb = *(const u32x2*)(ysl + (size_t)T * D + (size_t)row * D + col);
                const f32x4 h1 = (hp - mu1) * rs1 * g1[j] + b1[j];
                f32x4 y; y[0] = bf_lo(ya.x) + bf_lo(yb.x); y[1] = bf_hi(ya.x) + bf_hi(yb.x); y[2] = bf_lo(ya.y) + bf_lo(yb.y); y[3] = bf_hi(ya.y) + bf_hi(yb.y);
                v[j] = h1 * DN_ALPHA + y; s += (v[j][0] + v[j][1]) + (v[j][2] + v[j][3]); }
            const float mean = wave_sum(s) * (1.f / D); float q = 0.f;
#pragma unroll
            for (int j = 0; j < 4; ++j) { v[j] = v[j] - mean; q += sq4(v[j]); }
            const float rstd = fast_rsqrt(wave_sum(q) * (1.f / D) + LN_EPS);
#pragma unroll
            for (int j = 0; j < 4; ++j) *(f32x4*)(args.out + (size_t)row * D + 4 * lane + 256 * j) = v[j] * rstd * g2[j] + b2[j];
        }
    }
#undef IN
#undef SEAM
}

extern "C" void kernel_launch(void* const* d_in, const int* in_sizes, int n_in, void* d_out, int out_size, void* d_ws, size_t ws_size, hipStream_t stream) {
    static int grid = 0;
    if (grid == 0) {
        if (n_in != 24 || in_sizes[0] != T * D || out_size != T * D || ws_size < WS_END) { fprintf(stderr, "kernel_launch: unexpected shapes (n_in %d, in0 %d, out %d, ws %zu)\n", n_in, n_in > 0 ? in_sizes[0] : -1, out_size, ws_size); grid = -1; return; }
        int dev = 0, cus = 0, per_cu = 0;
        if (hipGetDevice(&dev) != hipSuccess || hipDeviceGetAttribute(&cus, hipDeviceAttributeMultiprocessorCount, dev) != hipSuccess) { grid = -1; return; }
        if (hipFuncSetAttribute((const void*)fwd_kernel, hipFuncAttributeMaxDynamicSharedMemorySize, LDS_BYTES) != hipSuccess) { fprintf(stderr, "kernel_launch: hipFuncSetAttribute failed\n"); grid = -1; return; }
        if (hipOccupancyMaxActiveBlocksPerMultiprocessor(&per_cu, (const void*)fwd_kernel, NWAVES * 64, LDS_BYTES) != hipSuccess || per_cu < 1)
            fprintf(stderr, "kernel_launch: note: occupancy query reports %d workgroups per CU\n", per_cu);
        (void)hipGetLastError();
        grid = cus;
    }
    if (grid < 0) return;
    if (hipMemsetAsync((char*)d_ws + WS_CTL, 0, CTL_ZERO_BYTES, stream) != hipSuccess) return;
    Args a{};
    for (int i = 0; i < 24; ++i) a.in[i] = (const float*)d_in[i];
    a.pos = (const int*)d_in[1]; a.out = (float*)d_out; a.ws = (unsigned char*)d_ws;
    if (N_LAUNCHES == 1) { a.ph_lo = 0; a.ph_hi = N_PHASES; hipLaunchKernelGGL(fwd_kernel, dim3(grid), dim3(NWAVES * 64), LDS_BYTES, stream, a); }
    else for (int p = 0; p < N_PHASES; ++p) { a.ph_lo = p; a.ph_hi = p + 1; hipLaunchKernelGGL(fwd_kernel, dim3(grid), dim3(NWAVES * 64), LDS_BYTES, stream, a); }
}
```

```cpp
#include <hip/hip_runtime.h>
#include <cstdio>
#include <cstdint>

#ifndef MK_N_LAUNCHES
#define MK_N_LAUNCHES 1
#endif
constexpr int N_PHASES = 9;
constexpr int N_LAUNCHES = MK_N_LAUNCHES;

#define LAS __attribute__((address_space(3)))
#define GAS __attribute__((address_space(1)))
typedef unsigned short bf16_t;
typedef short bf16x8 __attribute__((ext_vector_type(8)));
typedef float f32x4 __attribute__((ext_vector_type(4)));
typedef float f32x16 __attribute__((ext_vector_type(16)));
typedef unsigned u32x4 __attribute__((ext_vector_type(4)));
typedef unsigned u32x2 __attribute__((ext_vector_type(2)));

constexpr int NB = 2, S = 16384, T = NB * S, D = 1024;
constexpr int IN_COLS = 1824, N1 = 2048;
constexpr int NEXP = 32, EFF = 256;
constexpr float LN_EPS = 1e-5f, RMS_EPS = 1e-6f;
constexpr float DN_ALPHA = 1.189207115002721f;
constexpr float LOG2E = 1.4426950408889634f;
constexpr float SC_A = 0.125f * LOG2E;
constexpr float Q8_PRE = 2.0f, K8_PRE = 0.5f;
constexpr float SC_B = 0.10206207261596575f * LOG2E;

constexpr size_t MiB = 1u << 20;
constexpr size_t WS_CTL = 0, CTL_ZERO_BYTES = 1 * MiB;
constexpr size_t WS_XSTAT = 1 * MiB;
constexpr size_t WS_WRT = 1 * MiB + 512 * 1024;
constexpr size_t WS_COSA = 2 * MiB, WS_SINA = 6 * MiB, WS_COSB = 10 * MiB, WS_SINB = 12 * MiB;
constexpr size_t WS_W1T = 14 * MiB, WS_W2Q = 18 * MiB, WS_W2KV = 20 * MiB, WS_W4T = 21 * MiB, WS_WGU = 23 * MiB, WS_WD = 55 * MiB;
constexpr size_t WS_LTOK = 71 * MiB, WS_LW = 75 * MiB;
constexpr size_t WS_H0B = 80 * MiB;
constexpr size_t WS_CQ = 144 * MiB;
constexpr size_t WS_CKV = 192 * MiB;
constexpr size_t WS_QA = 208 * MiB, WS_KA = 240 * MiB, WS_VAT = 248 * MiB, WS_KR = 256 * MiB;
constexpr size_t WS_QB = 260 * MiB, WS_KN = 308 * MiB, WS_VBT = 340 * MiB;
constexpr size_t WS_H1PRE = 372 * MiB;
constexpr size_t WS_Y = 208 * MiB;
constexpr size_t WS_END = 500 * MiB;
constexpr int CW_BAR = 4096;
constexpr int CW_WINQ = 24576;
constexpr int CW_ECNT = 8192;
constexpr int CW_KN2 = 16384, CW_KR2 = 20480;
constexpr int CW_SSQ_Q = 65536, CW_SSQ_KV = CW_SSQ_Q + T, CW_SSQ_A = CW_SSQ_KV + T, CW_SSQ_B = CW_SSQ_A + T, CW_S1 = CW_SSQ_B + T, CW_S2 = CW_S1 + T;
static_assert((size_t)(CW_S2 + T) * 4 <= CTL_ZERO_BYTES, "ctl");

constexpr int RING_BYTES = 135168;
constexpr int MISC_OFF = RING_BYTES;
constexpr int LDS_BYTES = 147456;
constexpr int NWAVES = 8;

#define RLX_AGENT __ATOMIC_RELAXED, __HIP_MEMORY_SCOPE_AGENT
typedef float f32x2_t __attribute__((ext_vector_type(2))); typedef __bf16 bf16x2_t __attribute__((ext_vector_type(2)));
__device__ __forceinline__ unsigned cvt_pk_bf16(float lo, float hi) { const f32x2_t v = {lo, hi}; const bf16x2_t b = __builtin_convertvector(v, bf16x2_t); return __builtin_bit_cast(unsigned, b); }
__device__ __forceinline__ float bf_lo(unsigned w) { return __uint_as_float(w << 16); }
__device__ __forceinline__ float bf_hi(unsigned w) { return __uint_as_float(w & 0xffff0000u); }
__device__ __forceinline__ float wave_sum(float v) {
#pragma unroll
    for (int o = 1; o < 64; o <<= 1) v += __shfl_xor(v, o);
    return v;
}
__device__ __forceinline__ float fast_rsqrt(float x) { return __builtin_amdgcn_rsqf(x); }
__device__ __forceinline__ void wave_amax_nonneg(unsigned* p, float v, int lane) {
#pragma unroll
    for (int o = 1; o < 64; o <<= 1) v = fmaxf(v, __shfl_xor(v, o));
    if (lane == 0) atomicMax(p, __float_as_uint(v));
}
__device__ __forceinline__ int opaque(int v) { asm volatile("" : "+v"(v)); return v; }

#define XB_TMO      128
#define XB_XCNT(j)  (256  + 64 * (j))
#define XB_XSUB(j)  (1280 + 64 * (j))
#define XB_XGEN(j)  (2304 + 64 * (j))
#define XB_TOP      3328
#define XB_TOPGEN   3392
#define XCD_BAR_WORDS 3456
#define XB_SPIN_CAP (1u << 20)
__device__ __forceinline__ unsigned xb_ld(unsigned* p)              { return __hip_atomic_load(p, __ATOMIC_RELAXED, __HIP_MEMORY_SCOPE_AGENT); }
__device__ __forceinline__ unsigned xb_add(unsigned* p, unsigned v) { return __hip_atomic_fetch_add(p, v, __ATOMIC_RELAXED, __HIP_MEMORY_SCOPE_AGENT); }
__device__ __forceinline__ unsigned xb_xcc_id() { return (unsigned)__builtin_amdgcn_s_getreg((3 << 11) | 20) & 0xFu; }
#define XB_SPIN(cond, bar) do { unsigned _sp = 0; while (cond) { __builtin_amdgcn_s_sleep(1); \
    if ((++_sp & 255u) == 0u) { if (xb_ld(&(bar)[XB_TMO])) break; if (_sp > XB_SPIN_CAP) { atomicAdd(&(bar)[XB_TMO], 1u); break; } } } } while (0)
struct XcdBarrier { unsigned* bar; unsigned x; volatile LAS unsigned* st; };
__device__ __forceinline__ XcdBarrier xcd_barrier_post(unsigned* bar, volatile LAS unsigned* st) {
    XcdBarrier b; b.bar = bar; b.x = xb_xcc_id(); b.st = st;
    if (threadIdx.x == 0) (void)xb_add(&bar[XB_XCNT(b.x)], 1u);
    return b;
}
__device__ __forceinline__ void xcd_barrier_complete(unsigned* bar, unsigned x, unsigned& nloc, unsigned& nx) {
    const unsigned G = gridDim.x * gridDim.y * gridDim.z;
    unsigned sum, cnt, mine, sp = 0u;
    for (;;) {
        sum = 0u; cnt = 0u; mine = 0u;
#pragma unroll
        for (unsigned j = 0; j < 16; ++j) { const unsigned c = xb_ld(&bar[XB_XCNT(j)]); sum += c; cnt += (c > 0u) ? 1u : 0u; mine = (j == x) ? c : mine; }
        if (sum == G) break;
        __builtin_amdgcn_s_sleep(1);
        if ((++sp & 255u) == 0u) { if (xb_ld(&bar[XB_TMO])) break; if (sp > XB_SPIN_CAP) { atomicAdd(&bar[XB_TMO], 1u); break; } }
    }
    nloc = mine > 0u ? mine : 1u; nx = cnt > 0u ? cnt : 1u;
}
__device__ __forceinline__ void xcd_barrier(const XcdBarrier& b) {
    asm volatile("s_waitcnt vmcnt(0)" ::: "memory");
    __syncthreads();
    if (threadIdx.x == 0) {
        unsigned* bar = b.bar;
        __builtin_amdgcn_s_waitcnt(0);
        unsigned nloc = b.st[0], nx = b.st[1];
        if (nloc == 0u) { xcd_barrier_complete(bar, b.x, nloc, nx); b.st[0] = nloc; b.st[1] = nx; }
        const unsigned old = xb_add(&bar[XB_XSUB(b.x)], 1u);
        const unsigned gen = old / nloc;
        if (old + 1u == (gen + 1u) * nloc) {
            __builtin_amdgcn_fence(__ATOMIC_RELEASE, "agent");
            asm volatile("s_waitcnt vmcnt(0)" ::: "memory");
            const unsigned og = xb_add(&bar[XB_TOP], 1u);
            const unsigned tg = og / nx;
            if (og + 1u == (tg + 1u) * nx) xb_add(&bar[XB_TOPGEN], 1u);
            else XB_SPIN(xb_ld(&bar[XB_TOPGEN]) == tg, bar);
            __builtin_amdgcn_fence(__ATOMIC_ACQUIRE, "agent");
            xb_add(&bar[XB_XGEN(b.x)], 1u);
            asm volatile("s_waitcnt vmcnt(0)" ::: "memory");
        } else {
            XB_SPIN(xb_ld(&bar[XB_XGEN(b.x)]) == gen, bar);
            __builtin_amdgcn_fence(__ATOMIC_ACQUIRE, "agent");
            asm volatile("s_waitcnt vmcnt(0)" ::: "memory");
        }
    }
    __syncthreads();
}

namespace pg8 {
constexpr int BM = 256, BK = 64, HALF = 128, HTB = HALF * BK * 2, STAGE_BYTES = 8 * HTB, NXCD = 8, WGM = 8;
__device__ __forceinline__ int lds_byte(int r, int c) { const int st = (r >> 4) * 2 + (c >> 5), rr = r & 15, cc = c & 31, ob = rr * 64 + cc * 2; return st * 1024 + (ob ^ (((ob >> 9) & 1) << 5)); }
__device__ __forceinline__ void stage_rc(int b, int& R, int& C) { const int st = b / 1024, sb = b % 1024, swz = sb ^ (((sb >> 9) & 1) << 5); R = (st >> 1) * 16 + swz / 64; C = (st & 1) * 32 + (swz % 64) / 2; }
__device__ __forceinline__ int perm32(int rho) { const int n = rho >> 4, i = rho & 15; return 8 * (i >> 2) + 4 * n + (i & 3); }

struct Unit { int pm, pn, e, chunk, cnt; };

template <int K> struct DenseSched {
    static constexpr bool GATHER = false;
    const bf16_t* A; const bf16_t* Bt; int nM, nN, nwg, G, c;
    __device__ void init(const bf16_t* A_, const bf16_t* Bt_, int M, int N, int G_, int c_) { A = A_; Bt = Bt_; nM = M / BM; nN = N / BM; nwg = nM * nN; G = G_; c = c_; }
    __device__ bool next(int i, Unit& u) const {
        const long L = (long)i * G + c; if (L >= nwg) return false;
        int wgid = (int)L; { const int q = nwg / NXCD, r = nwg % NXCD, xcd = wgid % NXCD, off = wgid / NXCD; wgid = (xcd < r ? xcd * (q + 1) : r * (q + 1) + (xcd - r) * q) + off; }
        const int nig = WGM * nN, gid = wgid / nig, fm = gid * WGM, gsz = (nM - fm) < WGM ? (nM - fm) : WGM;
        u.pm = fm + ((wgid % nig) % gsz); u.pn = (wgid % nig) / gsz; u.e = 0; u.chunk = 0; u.cnt = 0; return true;
    }
    __device__ __forceinline__ const char* a_base(const Unit& u) const { return (const char*)A + (size_t)u.pm * BM * K * 2; }
    __device__ __forceinline__ const char* b_base(const Unit& u) const { return (const char*)Bt + (size_t)u.pn * BM * K * 2; }
    __device__ __forceinline__ void a_offs(const Unit&, const int (&R)[2], const int (&C)[2], unsigned (&v0)[2], unsigned (&v1)[2]) const {
#pragma unroll
        for (int i = 0; i < 2; ++i) { v0[i] = (unsigned)(R[i] * K + C[i]) * 2u; v1[i] = v0[i] + (unsigned)(HALF * K) * 2u; }
    }
};

template <class Epi, class Sched, bool ALIGN_EPI, int K>
__device__ __forceinline__ void gemm_phase(LAS unsigned char* lds, const Sched& S, const Epi& E) {
    const int tid = threadIdx.x, wid = __builtin_amdgcn_readfirstlane(tid >> 6), lane = tid & 63, wr = wid >> 2, wc = wid & 3, fr = lane & 15, fq = lane >> 4;
    constexpr int nt = K / BK;
    unsigned voffB[2]; int Rs[2], Cs[2];
#pragma unroll
    for (int i = 0; i < 2; ++i) { int R, C; stage_rc(tid * 16 + i * 8192, R, C); Rs[i] = R; Cs[i] = C; const int Rb = Epi::PERM ? ((R & ~31) + perm32(R & 31)) : R;
        voffB[i] = (unsigned)(Rb * K + C) * 2u; }
    const size_t kstep = (size_t)(BK * 2);
    const size_t hstepB = (size_t)HALF * K * 2;
    const unsigned ldsw = (unsigned)wid * 1024u;
    const int aoff = lds_byte(wr * 64 + fr, fq * 8), boff = lds_byte(wc * 32 + fr, fq * 8);
#define PG8_SA(b, h) (((b) * 2 + (h)) * HTB)
#define PG8_SB(b, h) ((4 + (b) * 2 + (h)) * HTB)
#define PG8_STAGE(bufoff, gbase, voff) do { _Pragma("unroll") for (int _i = 0; _i < 2; ++_i) \
        __builtin_amdgcn_global_load_lds((const unsigned*)((const char*)(gbase) + (voff)[_i]), (LAS unsigned*)(lds + (bufoff) + ldsw + _i * 8192), 16, 0, 0); } while (0)
#define PG8_LDA(dst, b, h) do { _Pragma("unroll") for (int m = 0; m < 4; ++m) _Pragma("unroll") for (int k = 0; k < 2; ++k) dst[m][k] = *(const LAS bf16x8*)(lds + PG8_SA(b, h) + aoff + m * 2048 + k * 1024); } while (0)
#define PG8_LDB(dst, b, h) do { _Pragma("unroll") for (int n = 0; n < 2; ++n) _Pragma("unroll") for (int k = 0; k < 2; ++k) dst[n][k] = *(const LAS bf16x8*)(lds + PG8_SB(b, h) + boff + n * 2048 + k * 1024); } while (0)
#define PG8_MMA(ai, bj, At, Bt) do { __builtin_amdgcn_s_setprio(1); _Pragma("unroll") for (int m = 0; m < 4; ++m) _Pragma("unroll") for (int n = 0; n < 2; ++n) _Pragma("unroll") for (int k = 0; k < 2; ++k) \
        acc[ai][bj][m][n] = __builtin_amdgcn_mfma_f32_16x16x32_bf16(Bt[n][k], At[m][k], acc[ai][bj][m][n], 0, 0, 0); __builtin_amdgcn_s_setprio(0); } while (0)
#define PG8_WAIT_V(n) asm volatile("s_waitcnt vmcnt(" #n ")" ::: "memory")
#define PG8_WAIT_L(n) asm volatile("s_waitcnt lgkmcnt(" #n ")" ::: "memory")
#define PG8_BAR __builtin_amdgcn_s_barrier()
#define PG8_SCHED __builtin_amdgcn_sched_barrier(0)
    Unit cur, nxt; int ui = 0;
    if (!S.next(0, cur)) return;
    f32x4 acc[2][2][4][2];
#pragma unroll
    for (int a = 0; a < 2; ++a)
#pragma unroll
        for (int b = 0; b < 2; ++b)
#pragma unroll
            for (int m = 0; m < 4; ++m)
#pragma unroll
                for (int n = 0; n < 2; ++n) acc[a][b][m][n] = (f32x4){0.f, 0.f, 0.f, 0.f};
    bf16x8 At[4][2], B0[2][2], B1[2][2];
    unsigned vA0[2], vA1[2], nA0[2], nA1[2];
    S.a_offs(cur, Rs, Cs, vA0, vA1);
    const char* cA = S.a_base(cur); const char* cB = S.b_base(cur);
    PG8_STAGE(PG8_SB(0, 0), cB, voffB); PG8_STAGE(PG8_SB(0, 1), cB + hstepB, voffB); PG8_STAGE(PG8_SA(0, 0), cA, vA0); PG8_STAGE(PG8_SA(0, 1), cA, vA1);
    if (wr == 1) PG8_BAR;
    PG8_WAIT_V(2); PG8_BAR;
    PG8_STAGE(PG8_SB(1, 0), cB + kstep, voffB); PG8_STAGE(PG8_SA(1, 0), cA + kstep, vA0); PG8_STAGE(PG8_SB(1, 1), cB + hstepB + kstep, voffB);
    PG8_WAIT_V(6); PG8_BAR;
    for (;;) {
        const bool has_next = S.next(ui + 1, nxt);
        const char* nA = has_next ? S.a_base(nxt) : cA; const char* nB = has_next ? S.b_base(nxt) : cB;
        if constexpr (Sched::GATHER) {
            if (has_next) S.a_offs(nxt, Rs, Cs, nA0, nA1);
            else {
#pragma unroll
                for (int i = 0; i < 2; ++i) { nA0[i] = vA0[i]; nA1[i] = vA1[i]; }
            }
        }
#pragma nounroll
        for (int t = 0; t < nt; t += 2) {
            const bool last = (t == nt - 2);
            if constexpr (Epi::MIDK) { if (t == nt / 2) E.mid(acc, cur, wr, wc, fr, fq); }
            const char* a1 = cA + (size_t)(t + 1) * kstep;
            const char* a2 = last ? nA : cA + (size_t)(t + 2) * kstep; const char* b2 = last ? nB : cB + (size_t)(t + 2) * kstep;
            const char* a3 = a2 + kstep; const char* b3 = b2 + kstep;
            unsigned s0[2], s1[2];
            if constexpr (Sched::GATHER) {
#pragma unroll
                for (int i = 0; i < 2; ++i) { s0[i] = last ? nA0[i] : vA0[i]; s1[i] = last ? nA1[i] : vA1[i]; }
            } else {
#pragma unroll
                for (int i = 0; i < 2; ++i) { s0[i] = vA0[i]; s1[i] = vA1[i]; }
            }
            PG8_LDB(B0, 0, 0); PG8_LDB(B1, 0, 1); PG8_SCHED; PG8_LDA(At, 0, 0); PG8_STAGE(PG8_SA(1, 1), a1, vA1);
            PG8_WAIT_V(8); PG8_WAIT_L(0); PG8_BAR; PG8_MMA(0, 0, At, B0); PG8_MMA(0, 1, At, B1); PG8_BAR; PG8_SCHED;
            PG8_LDA(At, 0, 1); PG8_STAGE(PG8_SB(0, 0), b2, voffB); PG8_STAGE(PG8_SB(0, 1), b2 + hstepB, voffB); PG8_STAGE(PG8_SA(0, 0), a2, s0);
            PG8_WAIT_V(8); PG8_WAIT_L(0); PG8_BAR; PG8_MMA(1, 0, At, B0); PG8_MMA(1, 1, At, B1); PG8_BAR; PG8_SCHED;
            PG8_LDB(B0, 1, 0); PG8_LDB(B1, 1, 1); PG8_SCHED; PG8_LDA(At, 1, 0); PG8_STAGE(PG8_SA(0, 1), a2, s1);
            PG8_WAIT_V(8); PG8_WAIT_L(0); PG8_BAR; PG8_MMA(0, 0, At, B0); PG8_MMA(0, 1, At, B1); PG8_BAR; PG8_SCHED;
            PG8_LDA(At, 1, 1); PG8_STAGE(PG8_SB(1, 0), b3, voffB); PG8_STAGE(PG8_SB(1, 1), b3 + hstepB, voffB); PG8_STAGE(PG8_SA(1, 0), a3, s0);
            PG8_WAIT_V(8); PG8_WAIT_L(0); PG8_BAR; PG8_MMA(1, 0, At, B0); PG8_MMA(1, 1, At, B1); PG8_BAR; PG8_SCHED;
        }
        if constexpr (ALIGN_EPI) { if (wr == 0) PG8_BAR; }
        E(acc, cur, wr, wc, fr, fq);
        if (!has_next) break;
#pragma unroll
        for (int a = 0; a < 2; ++a)
#pragma unroll
            for (int b = 0; b < 2; ++b)
#pragma unroll
                for (int m = 0; m < 4; ++m)
#pragma unroll
                    for (int n = 0; n < 2; ++n) acc[a][b][m][n] = (f32x4){0.f, 0.f, 0.f, 0.f};
        cur = nxt; cA = nA; cB = nB; ++ui;
        if constexpr (Sched::GATHER) {
#pragma unroll
            for (int i = 0; i < 2; ++i) { vA0[i] = nA0[i]; vA1[i] = nA1[i]; }
        }
        if constexpr (ALIGN_EPI) { if (wr == 1) PG8_BAR; }
    }
    PG8_WAIT_V(0);
    if constexpr (!ALIGN_EPI) { if (wr == 0) PG8_BAR; }
    PG8_BAR;
#undef PG8_SA
#undef PG8_SB
#undef PG8_STAGE
#undef PG8_LDA
#undef PG8_LDB
#undef PG8_MMA
#undef PG8_WAIT_V
#undef PG8_WAIT_L
#undef PG8_BAR
#undef PG8_SCHED
}
}
using pg8::Unit;

__device__ __forceinline__ u32x2 pack8_fp8(const f32x4 a, const f32x4 b, float sc);
__device__ __forceinline__ u32x2 rope4_fp8(const f32x4 x1, const f32x4 x2, const f32x4 c, const f32x4 s, float sc) {
    const f32x4 o1 = x1 * c - x2 * s, o2 = x1 * s + x2 * c; return pack8_fp8(o1, o2, sc);
}
__device__ __forceinline__ void rope4(const f32x4 x1, const f32x4 x2, const f32x4 c, const f32x4 s, float sc, u32x4& w) {
    const f32x4 o1 = (x1 * c - x2 * s) * sc, o2 = (x1 * s + x2 * c) * sc;
    w.x = cvt_pk_bf16(o1[0], o1[1]); w.y = cvt_pk_bf16(o1[2], o1[3]); w.z = cvt_pk_bf16(o2[0], o2[1]); w.w = cvt_pk_bf16(o2[2], o2[3]);
}
__device__ __forceinline__ u32x4 pack8(const f32x4 a, const f32x4 b, float sc) {
    u32x4 w; w.x = cvt_pk_bf16(a[0] * sc, a[1] * sc); w.y = cvt_pk_bf16(a[2] * sc, a[3] * sc); w.z = cvt_pk_bf16(b[0] * sc, b[1] * sc); w.w = cvt_pk_bf16(b[2] * sc, b[3] * sc); return w;
}
__device__ __forceinline__ u32x2 pack8_fp8(const f32x4 a, const f32x4 b, float sc) {
    int w0 = __builtin_amdgcn_cvt_pk_fp8_f32(a[0] * sc, a[1] * sc, 0, false); w0 = __builtin_amdgcn_cvt_pk_fp8_f32(a[2] * sc, a[3] * sc, w0, true);
    int w1 = __builtin_amdgcn_cvt_pk_fp8_f32(b[0] * sc, b[1] * sc, 0, false); w1 = __builtin_amdgcn_cvt_pk_fp8_f32(b[2] * sc, b[3] * sc, w1, true);
    u32x2 w; w.x = (unsigned)w0; w.y = (unsigned)w1; return w;
}
__device__ __forceinline__ float sq4(const f32x4 a) { return (a[0] * a[0] + a[1] * a[1]) + (a[2] * a[2] + a[3] * a[3]); }
__device__ __forceinline__ void store_vt8(bf16_t* base, const f32x4 a, const f32x4 b, float sc) {
    const u32x4 w = pack8(a, b, sc);
    base[0 * 64] = (bf16_t)(w.x & 0xffff); base[1 * 64] = (bf16_t)(w.x >> 16); base[2 * 64] = (bf16_t)(w.y & 0xffff); base[3 * 64] = (bf16_t)(w.y >> 16);
    base[4 * 64] = (bf16_t)(w.z & 0xffff); base[5 * 64] = (bf16_t)(w.z >> 16); base[6 * 64] = (bf16_t)(w.w & 0xffff); base[7 * 64] = (bf16_t)(w.w >> 16);
}

struct Epi1 {
    static constexpr bool PERM = true, MIDK = false;
    bf16_t *Qa, *Ka, *VaT, *cq, *ckv, *Kr; float *ssq_q, *ssq_kv; const float *cosA, *sinA, *cosB, *sinB; unsigned* kr2;
    __device__ __forceinline__ void mid(f32x4 (&)[2][2][4][2], const Unit&, int, int, int, int) const {}
    __device__ __forceinline__ void operator()(const f32x4 (&acc)[2][2][4][2], const Unit& u, int wr, int wc, int fr, int fq) const {
        const int pn = u.pn, row0 = opaque(u.pm * 256 + wr * 64 + fr);
        if (pn < 2) {
#pragma unroll
            for (int ai = 0; ai < 2; ++ai)
#pragma unroll
                for (int m = 0; m < 4; ++m) { const int row = row0 + ai * 128 + m * 16; const int a = (wc & 1) * 4 + fq;
                    const f32x4 c = *(const f32x4*)(cosA + (size_t)row * 32 + 4 * a), s = *(const f32x4*)(sinA + (size_t)row * 32 + 4 * a);
#pragma unroll
                    for (int bj = 0; bj < 2; ++bj) { const int hd = pn * 4 + bj * 2 + (wc >> 1); u32x4 w; rope4(acc[ai][bj][m][0], acc[ai][bj][m][1], c, s, SC_A, w);
                        *(u32x4*)(Qa + (size_t)row * 512 + hd * 64 + 8 * a) = w; } }
        } else if (pn == 2) {
#pragma unroll
            for (int ai = 0; ai < 2; ++ai)
#pragma unroll
                for (int m = 0; m < 4; ++m) { const int row = row0 + ai * 128 + m * 16; const int a = (wc & 1) * 4 + fq, kvh = wc >> 1, b = row / S, s_ = row % S;
                    const f32x4 c = *(const f32x4*)(cosA + (size_t)row * 32 + 4 * a), s = *(const f32x4*)(sinA + (size_t)row * 32 + 4 * a);
                    u32x4 w; rope4(acc[ai][0][m][0], acc[ai][0][m][1], c, s, 1.0f, w);
                    *(u32x4*)(Ka + ((size_t)(b * 2 + kvh) * S + s_) * 64 + 8 * a) = w;
                    store_vt8(VaT + ((size_t)(b * 2 + kvh) * (S / 64) + (s_ >> 6)) * 4096 + (size_t)(8 * a) * 64 + (s_ & 63), acc[ai][1][m][0], acc[ai][1][m][1], 1.0f); }
        } else if (pn < 7) {
            bf16_t* dst = (pn < 6) ? cq : ckv; const int ld = (pn < 6) ? 768 : 256; const int cbase = (pn < 6) ? (pn - 3) * 256 : 0; float* ssq = (pn < 6) ? ssq_q : ssq_kv;
#pragma unroll
            for (int ai = 0; ai < 2; ++ai)
#pragma unroll
                for (int m = 0; m < 4; ++m) { const int row = row0 + ai * 128 + m * 16; float q = 0.f;
#pragma unroll
                    for (int bj = 0; bj < 2; ++bj) { *(u32x4*)(dst + (size_t)row * ld + cbase + bj * 128 + wc * 32 + fq * 8) = pack8(acc[ai][bj][m][0], acc[ai][bj][m][1], 1.0f);
                        q += sq4(acc[ai][bj][m][0]) + sq4(acc[ai][bj][m][1]); }
                    q += __shfl_xor(q, 16); q += __shfl_xor(q, 32);
                    if (fq == 0) atomicAdd(ssq + row, q); }
        } else {
            if (wc == 0) {
                float nmax = 0.f;
#pragma unroll
                for (int ai = 0; ai < 2; ++ai)
#pragma unroll
                    for (int m = 0; m < 4; ++m) { const int row = row0 + ai * 128 + m * 16;
                        const f32x4 c = *(const f32x4*)(cosB + (size_t)row * 16 + 4 * fq), s = *(const f32x4*)(sinB + (size_t)row * 16 + 4 * fq);
                        *(u32x2*)((unsigned char*)Kr + (size_t)row * 32 + 8 * fq) = rope4_fp8(acc[ai][0][m][0], acc[ai][0][m][1], c, s, K8_PRE);
                        float q = sq4(acc[ai][0][m][0]) + sq4(acc[ai][0][m][1]);
                        q += __shfl_xor(q, 16); q += __shfl_xor(q, 32); nmax = fmaxf(nmax, q); }
                wave_amax_nonneg(kr2 + u.pm, nmax, (fq << 4) | fr);
            }
        }
    }
};
struct Epi2q {
    static constexpr bool PERM = true, MIDK = false;
    bf16_t* Qb; unsigned char* Qn8; const float* ssq_q; const float *cosB, *sinB;
    __device__ __forceinline__ void mid(f32x4 (&)[2][2][4][2], const Unit&, int, int, int, int) const {}
    __device__ __forceinline__ void operator()(const f32x4 (&acc)[2][2][4][2], const Unit& u, int wr, int wc, int fr, int fq) const {
        const int pn = u.pn, row0 = opaque(u.pm * 256 + wr * 64 + fr);
#pragma unroll
        for (int ai = 0; ai < 2; ++ai)
#pragma unroll
            for (int m = 0; m < 4; ++m) { const int row = row0 + ai * 128 + m * 16;
                const float rs = fast_rsqrt(ssq_q[row] * (1.0f / 768.0f) + RMS_EPS) * SC_B;
                if (pn < 2) {
#pragma unroll
                    for (int bj = 0; bj < 2; ++bj) { const int hd = pn * 4 + bj * 2 + (wc >> 1), d0 = (wc & 1) * 32 + 8 * fq;
                        *(u32x2*)(Qn8 + (size_t)row * 512 + hd * 64 + d0) = pack8_fp8(acc[ai][bj][m][0], acc[ai][bj][m][1], rs * Q8_PRE); }
                } else {
                    const f32x4 c = *(const f32x4*)(cosB + (size_t)row * 16 + 4 * fq), s = *(const f32x4*)(sinB + (size_t)row * 16 + 4 * fq);
#pragma unroll
                    for (int bj = 0; bj < 2; ++bj) { const int hd = bj * 4 + wc;
                        *(u32x2*)((unsigned char*)Qb + (size_t)row * 256 + hd * 32 + 8 * fq) = rope4_fp8(acc[ai][bj][m][0], acc[ai][bj][m][1], c, s, rs * Q8_PRE); }
                }
            }
    }
};
struct Epi2kv {
    static constexpr bool PERM = true, MIDK = false;
    bf16_t *Kn, *VbT; const float* ssq_kv; unsigned* kn2;
    __device__ __forceinline__ void mid(f32x4 (&)[2][2][4][2], const Unit&, int, int, int, int) const {}
    __device__ __forceinline__ void operator()(const f32x4 (&acc)[2][2][4][2], const Unit& u, int wr, int wc, int fr, int fq) const {
        const int pn = u.pn, row0 = opaque(u.pm * 256 + wr * 64 + fr);
        float nmax[2] = {0.f, 0.f};
#pragma unroll
        for (int ai = 0; ai < 2; ++ai)
#pragma unroll
            for (int m = 0; m < 4; ++m) { const int row = row0 + ai * 128 + m * 16, b = row / S, s_ = row % S;
                const float rs = fast_rsqrt(ssq_kv[row] * (1.0f / 256.0f) + RMS_EPS);
#pragma unroll
                for (int bj = 0; bj < 2; ++bj) { const int hd = (pn & 1) * 4 + bj * 2 + (wc >> 1), d0 = (wc & 1) * 32 + 8 * fq;
                    if (pn < 2) { *(u32x2*)((unsigned char*)Kn + ((size_t)(b * 8 + hd) * S + s_) * 64 + d0) = pack8_fp8(acc[ai][bj][m][0], acc[ai][bj][m][1], rs * K8_PRE);
                        float q = (sq4(acc[ai][bj][m][0]) + sq4(acc[ai][bj][m][1])) * rs * rs;
                        q += __shfl_xor(q, 16); q += __shfl_xor(q, 32); nmax[bj] = fmaxf(nmax[bj], q); }
                    else store_vt8(VbT + ((size_t)(b * 8 + hd) * (S / 64) + (s_ >> 6)) * 4096 + (size_t)d0 * 64 + (s_ & 63), acc[ai][bj][m][0], acc[ai][bj][m][1], rs); }
            }
        if (pn < 2) {
#pragma unroll
            for (int bj = 0; bj < 2; ++bj) wave_amax_nonneg(kn2 + ((size_t)u.pm * 8 + pn * 4 + bj * 2 + (wc >> 1)) * 2 + (wc & 1), nmax[bj], (fq << 4) | fr);
        }
    }
};
struct Epi4 {
    static constexpr bool PERM = true, MIDK = true;
    const float *x, *xstat, *g0, *b0, *ssq_a, *ssq_b; bf16_t* h1pre; float *s1, *s2;
    __device__ __forceinline__ void mid(f32x4 (&acc)[2][2][4][2], const Unit& u, int wr, int wc, int fr, int fq) const {
        const int row0 = opaque(u.pm * 256 + wr * 64 + fr);
#pragma unroll
        for (int ai = 0; ai < 2; ++ai)
#pragma unroll
            for (int m = 0; m < 4; ++m) { const int row = row0 + ai * 128 + m * 16;
                const float va = ssq_a[row] * (1.0f / 512.0f) + RMS_EPS, vb = ssq_b[row] * (1.0f / 512.0f) + RMS_EPS;
                const float ratio = __builtin_amdgcn_sqrtf(vb * __builtin_amdgcn_rcpf(va));
#pragma unroll
                for (int bj = 0; bj < 2; ++bj)
#pragma unroll
                    for (int n = 0; n < 2; ++n) acc[ai][bj][m][n] *= ratio; }
    }
    __device__ __forceinline__ void operator()(const f32x4 (&acc)[2][2][4][2], const Unit& u, int wr, int wc, int fr, int fq) const {
        const int row0 = opaque(u.pm * 256 + wr * 64 + fr), col0 = u.pn * 256 + wc * 32 + 8 * fq;
#pragma unroll
        for (int ai = 0; ai < 2; ++ai)
#pragma unroll
            for (int m = 0; m < 4; ++m) { const int row = row0 + ai * 128 + m * 16;
                const float rb = fast_rsqrt(ssq_b[row] * (1.0f / 512.0f) + RMS_EPS);
                const float mean = xstat[2 * row], rstd = xstat[2 * row + 1];
                float t1 = 0.f, t2 = 0.f;
#pragma unroll
                for (int bj = 0; bj < 2; ++bj) { f32x4 v[2];
#pragma unroll
                    for (int n = 0; n < 2; ++n) { const int col = col0 + bj * 128 + n * 4;
                        const f32x4 xv = *(const f32x4*)(x + (size_t)row * D + col), g = *(const f32x4*)(g0 + col), b = *(const f32x4*)(b0 + col);
                        const f32x4 h0 = (xv - mean) * rstd * g + b;
                        v[n] = h0 * DN_ALPHA + acc[ai][bj][m][n] * rb;
                        t1 += (v[n][0] + v[n][1]) + (v[n][2] + v[n][3]); t2 += sq4(v[n]); }
                    *(u32x4*)(h1pre + (size_t)row * D + col0 + bj * 128) = pack8(v[0], v[1], 1.0f); }
                t1 += __shfl_xor(t1, 16); t1 += __shfl_xor(t1, 32); t2 += __shfl_xor(t2, 16); t2 += __shfl_xor(t2, 32);
                if (fq == 0) { atomicAdd(s1 + row, t1); atomicAdd(s2 + row, t2); } }
    }
};
struct EpiGU {
    static constexpr bool PERM = true, MIDK = false;
    bf16_t* hid;
    __device__ __forceinline__ void mid(f32x4 (&)[2][2][4][2], const Unit&, int, int, int, int) const {}
    __device__ __forceinline__ void operator()(const f32x4 (&acc)[2][2][4][2], const Unit& u, int wr, int wc, int fr, int fq) const {
        const int row0 = opaque(u.pm * 256 + wr * 64 + fr), col = u.pn * 128 + wc * 32 + fq * 8;
#pragma unroll
        for (int ai = 0; ai < 2; ++ai)
#pragma unroll
            for (int m = 0; m < 4; ++m) { const int row = row0 + ai * 128 + m * 16; f32x4 h[2];
#pragma unroll
                for (int n = 0; n < 2; ++n)
#pragma unroll
                    for (int e = 0; e < 4; ++e) { const float g = acc[ai][0][m][n][e], up = acc[ai][1][m][n][e]; h[n][e] = g * up * __builtin_amdgcn_rcpf(1.0f + __builtin_amdgcn_exp2f(-g * LOG2E)); }
                *(u32x4*)(hid + (size_t)row * EFF + col) = pack8(h[0], h[1], 1.0f); }
    }
};
struct EpiD {
    static constexpr bool PERM = true, MIDK = false;
    const unsigned* ltok; const float* lw; bf16_t* y;
    __device__ __forceinline__ void mid(f32x4 (&)[2][2][4][2], const Unit&, int, int, int, int) const {}
    __device__ __forceinline__ void operator()(const f32x4 (&acc)[2][2][4][2], const Unit& u, int wr, int wc, int fr, int fq) const {
        const int i0 = opaque(wr * 64 + fr), col0 = u.pn * 256 + wc * 32 + fq * 8;
#pragma unroll
        for (int ai = 0; ai < 2; ++ai)
#pragma unroll
            for (int m = 0; m < 4; ++m) { const int li = u.chunk * 256 + i0 + ai * 128 + m * 16;
                if (li < u.cnt) { const unsigned ent = ltok[(size_t)u.e * T + li]; const float w = lw[(size_t)u.e * T + li];
                    bf16_t* dst = y + (size_t)(ent >> 15) * ((size_t)T * D) + (size_t)(ent & 0x7fffu) * D + col0;
#pragma unroll
                    for (int bj = 0; bj < 2; ++bj) *(u32x4*)(dst + bj * 128) = pack8(acc[ai][bj][m][0], acc[ai][bj][m][1], w); } }
    }
};

template <int MODE> struct MoeSched {
    static constexpr bool GATHER = (MODE == 0);
    const LAS int* tab;
    const bf16_t* A; const bf16_t* W; const unsigned* ltok; int G, c, npn;
    int mode;
    __device__ bool next(int i, Unit& u) const {
        const int ntl = tab[32]; int tau, pn;
        if (mode == 0) { const long L = (long)i * G + c; if (L >= (long)ntl * npn) return false; tau = (int)(L / npn); pn = (int)(L % npn); }
        else {
            const int nx = 2 * (ntl - G);
            if (mode == 1) { if (i < 2) { tau = c; pn = i; } else if (i == 2 && c < nx) { tau = G + (c >> 1); pn = c & 1; } else return false; }
            else if (mode == 2) { if (c < nx || i >= 4) return false; tau = c; pn = i; }
            else { const int L = i * G + c; if (L >= (nx + (ntl - G)) * 4) return false; const int ti = L >> 2; pn = L & 3; tau = ti < nx ? ti : G + (ti - nx); }
        }
        int e = 0;
        for (int k = 1; k < 32; ++k) e += (tab[k] <= tau) ? 1 : 0;
        u.pm = tau; u.pn = pn; u.e = e; u.chunk = tau - tab[e]; u.cnt = tab[64 + e]; return true;
    }
    __device__ __forceinline__ const char* a_base(const Unit& u) const { return MODE == 0 ? (const char*)A : (const char*)A + (size_t)u.pm * 256 * EFF * 2; }
    __device__ __forceinline__ const char* b_base(const Unit& u) const {
        return MODE == 0 ? (const char*)W + ((size_t)u.e * 512 + (size_t)u.pn * 256) * D * 2 : (const char*)W + ((size_t)u.e * D + (size_t)u.pn * 256) * EFF * 2; }
    __device__ __forceinline__ void a_offs(const Unit& u, const int (&R)[2], const int (&C)[2], unsigned (&v0)[2], unsigned (&v1)[2]) const {
        if constexpr (MODE == 0) {
#pragma unroll
            for (int i = 0; i < 2; ++i) { const int l0 = u.chunk * 256 + R[i], l1 = l0 + 128;
                const unsigned t0 = l0 < u.cnt ? (ltok[(size_t)u.e * T + l0] & 0x7fffu) : 0u, t1 = l1 < u.cnt ? (ltok[(size_t)u.e * T + l1] & 0x7fffu) : 0u;
                v0[i] = (t0 * (unsigned)D + (unsigned)C[i]) * 2u; v1[i] = (t1 * (unsigned)D + (unsigned)C[i]) * 2u; }
        } else {
#pragma unroll
            for (int i = 0; i < 2; ++i) { v0[i] = (unsigned)(R[i] * EFF + C[i]) * 2u; v1[i] = v0[i] + (unsigned)(128 * EFF) * 2u; }
        }
    }
};

#define MF32(a, b, c) __builtin_amdgcn_mfma_f32_32x32x16_bf16(a, b, c, 0, 0, 0)
#define SBAR() __builtin_amdgcn_sched_barrier(0)
#define LDF(p) (*(const LAS bf16x8*)(p))
__device__ __forceinline__ float max3f(float a, float b, float c) { return fmaxf(fmaxf(a, b), c); }
__device__ __forceinline__ float fadd_s(float a, float b) { float r; asm("v_add_f32_e32 %0, %1, %2" : "=v"(r) : "v"(a), "v"(b)); return r; }
__device__ __forceinline__ float xhalf_max(float v) { auto rr = __builtin_amdgcn_permlane32_swap(__float_as_uint(v), __float_as_uint(v), false, false); return fmaxf(__uint_as_float(rr[0]), __uint_as_float(rr[1])); }
constexpr float MLA_THRL = 8.0f;
#define PIN2(a, b) asm volatile("" : "+v"(a), "+v"(b))
struct MlaSrc { const bf16_t *Kn, *Krp, *Vt; };
struct MlaDma { int ko, k2, kstride, kdst, wv; };
typedef float f32x2 __attribute__((ext_vector_type(2)));
#define M2_MAX_A(SN, TM) do { float a_ = max3f(SN[0], SN[1], SN[2]), b_ = max3f(SN[3], SN[4], SN[5]); a_ = max3f(a_, SN[6], SN[7]); b_ = max3f(b_, SN[8], SN[9]); TM = fmaxf(a_, b_); } while (0)
#define M2_MAX_B(SN, TM) do { float a_ = max3f(SN[10], SN[11], SN[12]); TM = max3f(TM, SN[13], SN[14]); a_ = fmaxf(a_, SN[15]); TM = fmaxf(TM, a_); TM = xhalf_max(TM); } while (0)
#define M4_E(C, j) do { C[4 * (j) + 0] = __builtin_amdgcn_exp2f(C[4 * (j) + 0]); C[4 * (j) + 1] = __builtin_amdgcn_exp2f(C[4 * (j) + 1]); C[4 * (j) + 2] = __builtin_amdgcn_exp2f(C[4 * (j) + 2]); C[4 * (j) + 3] = __builtin_amdgcn_exp2f(C[4 * (j) + 3]); } while (0)
#define M4_F(C, j, S0, S1, W0, W1) do { S0 = fadd_s(S0, C[4 * (j) + 0]); S1 = fadd_s(S1, C[4 * (j) + 1]); S0 = fadd_s(S0, C[4 * (j) + 2]); S1 = fadd_s(S1, C[4 * (j) + 3]); \
    if ((j) < 2) { W0[2 * ((j) & 1)] = cvt_pk_bf16(C[4 * (j) + 0], C[4 * (j) + 1]); W0[2 * ((j) & 1) + 1] = cvt_pk_bf16(C[4 * (j) + 2], C[4 * (j) + 3]); PIN2(W0[2 * ((j) & 1)], W0[2 * ((j) & 1) + 1]); } \
    else { W1[2 * ((j) & 1)] = cvt_pk_bf16(C[4 * (j) + 0], C[4 * (j) + 1]); W1[2 * ((j) & 1) + 1] = cvt_pk_bf16(C[4 * (j) + 2], C[4 * (j) + 3]); PIN2(W1[2 * ((j) & 1)], W1[2 * ((j) & 1) + 1]); } } while (0)
constexpr int AT3_KR = 4096, AT3_VT = 6144, AT3_BUF = 14336;
#define BUF3(k) (lds + (k) * AT3_BUF)
typedef int i32x8 __attribute__((ext_vector_type(8)));
#define MFS(a, b, c) __builtin_amdgcn_mfma_scale_f32_32x32x64_f8f6f4(a, b, c, 0, 0, 0, 127, 0, 127)
#define CAT8(x, y) ((i32x8){(int)(x)[0], (int)(x)[1], (int)(x)[2], (int)(x)[3], (int)(y)[0], (int)(y)[1], (int)(y)[2], (int)(y)[3]})
#define LDU(p) (*(const LAS u32x4*)(p))
#define MF8(a, b, c) __builtin_amdgcn_mfma_f32_32x32x16_fp8_fp8(a, b, c, 0, 0, 0)
#define PK64(lo, hi) ((long)(((unsigned long long)(hi) << 32) | (unsigned long long)(lo)))
#define KR8(j) PK64(kR[2 * (j)], kR[2 * (j) + 1])
__device__ __forceinline__ void mla_dma8(const MlaDma& dm, const MlaSrc& s, LAS unsigned char* buf, int t) {
    __builtin_amdgcn_global_load_lds((const unsigned*)(s.Vt + (size_t)t * 4096 + dm.ko), (LAS unsigned*)(buf + AT3_VT + dm.wv * 1024), 16, 0, 0);
    const unsigned char* kb = (dm.wv < 4) ? (const unsigned char*)s.Kn : (const unsigned char*)s.Krp;
    __builtin_amdgcn_global_load_lds((const unsigned*)(kb + (size_t)t * dm.kstride + dm.k2), (LAS unsigned*)(buf + dm.kdst), 16, 0, 0);
}
template <bool HAS_NEXT, bool PRELOAD, bool BAR>
__device__ __forceinline__ void mla8_step(f32x16& ca, f32x16& cb, f32x16& na, f32x16& nb, f32x16& oa0, f32x16& oa1, f32x16& ob0, f32x16& ob1,
                                          float& ma, float& mb, float& la, float& lb, const i32x8& qa8, const i32x8& qb8, const long (&qar)[2], const long (&qbr)[2], u32x4 (&kN)[2], u32x4& kR,
                                          const LAS unsigned char* vbuf, const LAS unsigned char* nkn, const LAS unsigned char* nkr, const int (&kon)[2], int kor, const int (&vo)[2],
                                          const MlaDma& dm, const MlaSrc& dsrc, LAS unsigned char* wbuf, bool do_dma, int tdma, bool track) {
    float sa0 = 0.f, sa1 = 0.f, sb0 = 0.f, sb1 = 0.f; u32x4 pa0, pa1, pb0, pb1; bf16x8 vf[4];
    f32x16 zero16;
#pragma unroll
    for (int r = 0; r < 16; ++r) zero16[r] = 0.f;
    if (HAS_NEXT) {
        const i32x8 k8 = CAT8(kN[0], kN[1]);
        na = MFS(k8, qa8, zero16); SBAR();
        vf[0] = LDF(vbuf + vo[0]); vf[2] = LDF(vbuf + vo[0] + 4096); vf[1] = LDF(vbuf + vo[1]); vf[3] = LDF(vbuf + vo[1] + 4096);
        M4_E(ca, 0); M4_E(ca, 1); SBAR();
        nb = MFS(k8, qb8, zero16); M4_F(ca, 0, sa0, sa1, pa0, pa1); M4_E(ca, 2); SBAR();
        na = MF8(KR8(0), qar[0], na); M4_F(ca, 1, sa0, sa1, pa0, pa1); SBAR();
        nb = MF8(KR8(0), qbr[0], nb); M4_E(ca, 3); SBAR();
        na = MF8(KR8(1), qar[1], na); M4_F(ca, 2, sa0, sa1, pa0, pa1); SBAR();
        nb = MF8(KR8(1), qbr[1], nb); M4_F(ca, 3, sa0, sa1, pa0, pa1); SBAR();
    } else {
        vf[0] = LDF(vbuf + vo[0]); vf[2] = LDF(vbuf + vo[0] + 4096); vf[1] = LDF(vbuf + vo[1]); vf[3] = LDF(vbuf + vo[1] + 4096);
        M4_E(ca, 0); M4_E(ca, 1); M4_E(ca, 2); M4_E(ca, 3);
        M4_F(ca, 0, sa0, sa1, pa0, pa1); M4_F(ca, 1, sa0, sa1, pa0, pa1); M4_F(ca, 2, sa0, sa1, pa0, pa1); M4_F(ca, 3, sa0, sa1, pa0, pa1);
    }
    if (BAR) {
        asm volatile("s_waitcnt vmcnt(0)" ::: "memory");
        __syncthreads();
        if (do_dma) mla_dma8(dm, dsrc, wbuf, tdma);
    }
    SBAR();
    const bf16x8 xa0 = __builtin_bit_cast(bf16x8, pa0), xa1 = __builtin_bit_cast(bf16x8, pa1);
    oa0 = MF32(vf[0], xa0, oa0); SBAR();
    if (PRELOAD) { kN[0] = LDU(nkn + kon[0]); kN[1] = LDU(nkn + kon[1]); kR = LDU(nkr + kor); }
    M4_E(cb, 0); SBAR();
    oa1 = MF32(vf[2], xa0, oa1); M4_E(cb, 1); M4_F(cb, 0, sb0, sb1, pb0, pb1); SBAR();
    oa0 = MF32(vf[1], xa1, oa0); M4_F(cb, 1, sb0, sb1, pb0, pb1); M4_E(cb, 2); SBAR();
    oa1 = MF32(vf[3], xa1, oa1); M4_E(cb, 3); SBAR();
    const bf16x8 xb0 = __builtin_bit_cast(bf16x8, pb0);
    ob0 = MF32(vf[0], xb0, ob0); M4_F(cb, 2, sb0, sb1, pb0, pb1); SBAR();
    ob1 = MF32(vf[2], xb0, ob1); M4_F(cb, 3, sb0, sb1, pb0, pb1); SBAR();
    const bf16x8 xb1 = __builtin_bit_cast(bf16x8, pb1);
    ob0 = MF32(vf[1], xb1, ob0); SBAR();
    ob1 = MF32(vf[3], xb1, ob1); la += sa0 + sa1; lb += sb0 + sb1; SBAR();
    if (HAS_NEXT && track) {
#pragma unroll
        for (int r = 0; r < 16; ++r) { na[r] -= ma; nb[r] -= mb; }
        float ta, tb; M2_MAX_A(na, ta); M2_MAX_B(na, ta); M2_MAX_A(nb, tb); M2_MAX_B(nb, tb);
        if (__any(ta > MLA_THRL || tb > MLA_THRL)) {
            const float da = fmaxf(ta, 0.f), db_ = fmaxf(tb, 0.f), fa = __builtin_amdgcn_exp2f(-da), fb = __builtin_amdgcn_exp2f(-db_);
            ma += da; mb += db_; la *= fa; lb *= fb;
#pragma unroll
            for (int r = 0; r < 16; ++r) { na[r] -= da; nb[r] -= db_; oa0[r] *= fa; oa1[r] *= fa; ob0[r] *= fb; ob1[r] *= fb; }
        }
    }
}
__device__ __forceinline__ void mla8_unit(LAS unsigned char* lds, const unsigned char* Qr8u  , const unsigned char* Q8u  , const MlaSrc cs,
                                          float kn_bound, float kr_bound, bf16_t* Ou, float* ssqu) {
    constexpr int NT = S / 64;
    const int tid = opaque((int)threadIdx.x), lane = tid & 63, r32 = lane & 31, hi = lane >> 5, wv = __builtin_amdgcn_readfirstlane(tid >> 6);
    long qar[2], qbr[2]; u32x4 qna[2], qnb[2], qra, qrb;
#pragma unroll
    for (int g = 0; g < 2; ++g) { qna[g] = *(const u32x4*)(Q8u + (size_t)(64 * wv + r32) * 512 + 32 * hi + 16 * g); qnb[g] = *(const u32x4*)(Q8u + (size_t)(64 * wv + 32 + r32) * 512 + 32 * hi + 16 * g); }
    const i32x8 qa8 = CAT8(qna[0], qna[1]), qb8 = CAT8(qnb[0], qnb[1]);
    qra = *(const u32x4*)(Qr8u + (size_t)(64 * wv + r32) * 256 + 16 * hi); qrb = *(const u32x4*)(Qr8u + (size_t)(64 * wv + 32 + r32) * 256 + 16 * hi);
#pragma unroll
    for (int j = 0; j < 2; ++j) { qar[j] = PK64(qra[2 * j], qra[2 * j + 1]); qbr[j] = PK64(qrb[2 * j], qrb[2 * j + 1]); }
    MlaDma dm; dm.wv = wv;
    { const int row = 8 * wv + (lane >> 3), lg = (lane & 7) ^ ((row >> 1) & 7); dm.ko = row * 64 + lg * 8;
      const int rr = 16 * wv + (lane >> 2), lr = (lane & 3) ^ ((rr >> 2) & 3);
      const int r8 = 32 * (wv & 1) + (lane >> 1), l8 = (lane & 1) ^ ((r8 >> 3) & 1);
      dm.k2 = (wv < 4) ? rr * 64 + lr * 16 : r8 * 32 + l8 * 16;
      dm.kstride = (wv < 4) ? 4096 : 2048; dm.kdst = (wv < 4) ? wv * 1024 : AT3_KR + (wv & 1) * 1024; }
    const int pr = (r32 & ~12) | ((r32 & 4) << 1) | ((r32 & 8) >> 1);
    int kon[2], kor, vo0[2], vo1[2];
#pragma unroll
    for (int g = 0; g < 2; ++g) kon[g] = pr * 64 + (((2 * hi + g) ^ ((pr >> 2) & 3)) << 4);
    kor = AT3_KR + pr * 32 + ((hi ^ ((pr >> 3) & 1)) << 4);
#pragma unroll
    for (int s = 0; s < 2; ++s) { vo0[s] = AT3_VT + r32 * 128 + (((2 * s + hi) ^ ((r32 >> 1) & 7)) << 4); vo1[s] = AT3_VT + r32 * 128 + (((4 + 2 * s + hi) ^ ((r32 >> 1) & 7)) << 4); }
    __syncthreads();
    mla_dma8(dm, cs, lds, 0); mla_dma8(dm, cs, lds + AT3_BUF, 1);
    asm volatile("s_waitcnt vmcnt(0)" ::: "memory");
    __syncthreads();
    bool fast;
    { float an2 = 0.f, ar2 = 0.f, bn2 = 0.f, br2 = 0.f;
#pragma unroll
      for (int g = 0; g < 2; ++g)
#pragma unroll
          for (int e = 0; e < 4; ++e) {
              const int wa = (int)qna[g][e], wb = (int)qnb[g][e];
              const float a0 = __builtin_amdgcn_cvt_f32_fp8(wa, 0), a1 = __builtin_amdgcn_cvt_f32_fp8(wa, 1), a2 = __builtin_amdgcn_cvt_f32_fp8(wa, 2), a3 = __builtin_amdgcn_cvt_f32_fp8(wa, 3);
              const float b0 = __builtin_amdgcn_cvt_f32_fp8(wb, 0), b1 = __builtin_amdgcn_cvt_f32_fp8(wb, 1), b2 = __builtin_amdgcn_cvt_f32_fp8(wb, 2), b3 = __builtin_amdgcn_cvt_f32_fp8(wb, 3);
              an2 += (a0 * a0 + a1 * a1) + (a2 * a2 + a3 * a3); bn2 += (b0 * b0 + b1 * b1) + (b2 * b2 + b3 * b3); }
#pragma unroll
      for (int e = 0; e < 4; ++e) {
          const int wa = (int)qra[e], wb = (int)qrb[e];
          const float a0 = __builtin_amdgcn_cvt_f32_fp8(wa, 0), a1 = __builtin_amdgcn_cvt_f32_fp8(wa, 1), a2 = __builtin_amdgcn_cvt_f32_fp8(wa, 2), a3 = __builtin_amdgcn_cvt_f32_fp8(wa, 3);
          const float b0 = __builtin_amdgcn_cvt_f32_fp8(wb, 0), b1 = __builtin_amdgcn_cvt_f32_fp8(wb, 1), b2 = __builtin_amdgcn_cvt_f32_fp8(wb, 2), b3 = __builtin_amdgcn_cvt_f32_fp8(wb, 3);
          ar2 += (a0 * a0 + a1 * a1) + (a2 * a2 + a3 * a3); br2 += (b0 * b0 + b1 * b1) + (b2 * b2 + b3 * b3); }
      an2 += __shfl_xor(an2, 32); ar2 += __shfl_xor(ar2, 32); bn2 += __shfl_xor(bn2, 32); br2 += __shfl_xor(br2, 32);
      const float ba = (sqrtf(an2) * kn_bound + sqrtf(ar2) * kr_bound) * (1.15f / Q8_PRE), bb = (sqrtf(bn2) * kn_bound + sqrtf(br2) * kr_bound) * (1.15f / Q8_PRE);
      fast = __builtin_amdgcn_readfirstlane((int)__all(ba < 64.0f && bb < 64.0f)) != 0; }
    f32x16 pA0, pA1, pB0, pB1, oa0, oa1, ob0, ob1;
#pragma unroll
    for (int r = 0; r < 16; ++r) { pA0[r] = 0.f; pA1[r] = 0.f; oa0[r] = 0.f; oa1[r] = 0.f; ob0[r] = 0.f; ob1[r] = 0.f; }
    float ma = 0.f, mb = 0.f, la = 0.f, lb = 0.f;
    {
        { u32x4 kN[2]; kN[0] = LDU(lds + kon[0]); kN[1] = LDU(lds + kon[1]);
          { const i32x8 k8 = CAT8(kN[0], kN[1]); pA0 = MFS(k8, qa8, pA0); pA1 = MFS(k8, qb8, pA1); }
          { const u32x4 kR = LDU(lds + kor);
#pragma unroll
            for (int j = 0; j < 2; ++j) { pA0 = MF8(KR8(j), qar[j], pA0); pA1 = MF8(KR8(j), qbr[j], pA1); } } }
        if (!fast) {
            float ta, tb; M2_MAX_A(pA0, ta); M2_MAX_B(pA0, ta); M2_MAX_A(pA1, tb); M2_MAX_B(pA1, tb); ma = ta; mb = tb;
#pragma unroll
            for (int r = 0; r < 16; ++r) { pA0[r] -= ma; pA1[r] -= mb; }
        }
    }
    u32x4 kN[2], kR;
    kN[0] = LDU(lds + 2048 + kon[0]); kN[1] = LDU(lds + 2048 + kon[1]); kR = LDU(lds + 1024 + kor);
#define M6_ARGS(A0, A1, B0, B1) A0, A1, B0, B1, oa0, oa1, ob0, ob1, ma, mb, la, lb, qa8, qb8, qar, qbr, kN, kR
#define M6_TILE(B, N, W, DO, TD) do { \
        mla8_step<true, true, true>(M6_ARGS(pA0, pA1, pB0, pB1), BUF3(B), BUF3(N), BUF3(N), kon, kor, vo0, dm, cs, BUF3(W), DO, TD, !fast); \
        mla8_step<true, true, false>(M6_ARGS(pB0, pB1, pA0, pA1), BUF3(B), BUF3(N) + 2048, BUF3(N) + 1024, kon, kor, vo1, dm, cs, BUF3(W), false, 0, !fast); } while (0)
#pragma nounroll
    for (int t = 0; t < NT - 1; t += 3) {
        M6_TILE(0, 1, 2, true, t + 2);
        M6_TILE(1, 2, 0, true, t + 3);
        M6_TILE(2, 0, 1, t + 4 < NT, t + 4);
    }
    mla8_step<true, false, true>(M6_ARGS(pA0, pA1, pB0, pB1), BUF3(0), BUF3(1), BUF3(1), kon, kor, vo0, dm, cs, BUF3(2), false, 0, !fast);
    mla8_step<false, false, false>(M6_ARGS(pB0, pB1, pA0, pA1), BUF3(0), BUF3(1), BUF3(1), kon, kor, vo1, dm, cs, BUF3(2), false, 0, !fast);
    la += __shfl_xor(la, 32); lb += __shfl_xor(lb, 32);
    const int lane_m = opaque((int)threadIdx.x) & 63, r32m = lane_m & 31, him = lane_m >> 5;
#pragma unroll
    for (int blk = 0; blk < 2; ++blk) {
        f32x16& o0 = blk ? ob0 : oa0; f32x16& o1 = blk ? ob1 : oa1; const float inv = 1.0f / (blk ? lb : la);
        float qs = 0.f;
#pragma unroll
        for (int r = 0; r < 16; ++r) { o0[r] *= inv; o1[r] *= inv; qs += o0[r] * o0[r] + o1[r] * o1[r]; }
        qs += __shfl_xor(qs, 32);
        if (him == 0) atomicAdd(ssqu + 64 * wv + 32 * blk + r32m, qs);
        bf16_t* orow = Ou + (size_t)(64 * wv + 32 * blk + r32m) * D + 4 * him;
#pragma unroll
        for (int g = 0; g < 4; ++g) {
            u32x2 w0, w1;
            w0.x = cvt_pk_bf16(o0[4 * g], o0[4 * g + 1]); w0.y = cvt_pk_bf16(o0[4 * g + 2], o0[4 * g + 3]); w1.x = cvt_pk_bf16(o1[4 * g], o1[4 * g + 1]); w1.y = cvt_pk_bf16(o1[4 * g + 2], o1[4 * g + 3]);
            *(u32x2*)(orow + 8 * g) = w0; *(u32x2*)(orow + 32 + 8 * g) = w1;
        }
    }
}

constexpr int WN_TILE = 16384, WN_VT = 8192;
template <bool MASK>
__device__ __forceinline__ void win_tile(const LAS unsigned char* tb, const int (&kon)[4], const int (&vo)[4], const bf16x8 (&q)[4], f32x16& o0, f32x16& o1, float& mrun, float& lrun, int dj) {
    f32x16 p0, p1;
#pragma unroll
    for (int r = 0; r < 16; ++r) { p0[r] = 0.f; p1[r] = 0.f; }
#pragma unroll
    for (int d0 = 0; d0 < 4; ++d0) { p0 = MF32(LDF(tb + kon[d0]), q[d0], p0); p1 = MF32(LDF(tb + kon[d0] + 4096), q[d0], p1); }
    if (MASK) {
#pragma unroll
        for (int r = 0; r < 16; ++r) { const int d = dj + (r & 7) + 16 * (r >> 3);
            if (d < -128 || d > 128) p0[r] = -INFINITY;
            if (d + 32 < -128 || d + 32 > 128) p1[r] = -INFINITY; }
    }
    float tm = max3f(p0[0], p1[0], p0[1]);
#pragma unroll
    for (int r = 1; r < 15; r += 2) { tm = max3f(tm, p1[r], p0[r + 1]); tm = max3f(tm, p1[r + 1], p0[r + 2 > 15 ? 15 : r + 2]); }
    tm = fmaxf(tm, p1[15]);
    tm = xhalf_max(tm);
    const float mn = fmaxf(mrun, tm), alpha = __builtin_amdgcn_exp2f(mrun - mn);
    mrun = mn;
    float rs = 0.f;
#pragma unroll
    for (int r = 0; r < 16; ++r) { p0[r] = __builtin_amdgcn_exp2f(p0[r] - mn); p1[r] = __builtin_amdgcn_exp2f(p1[r] - mn); rs += p0[r] + p1[r]; }
    lrun = lrun * alpha + rs;
#pragma unroll
    for (int r = 0; r < 16; ++r) { o0[r] *= alpha; o1[r] *= alpha; }
#pragma unroll
    for (int s = 0; s < 2; ++s) {
        u32x4 w0, w1;
        w0.x = cvt_pk_bf16(p0[8 * s + 0], p0[8 * s + 1]); w0.y = cvt_pk_bf16(p0[8 * s + 2], p0[8 * s + 3]); w0.z = cvt_pk_bf16(p0[8 * s + 4], p0[8 * s + 5]); w0.w = cvt_pk_bf16(p0[8 * s + 6], p0[8 * s + 7]);
        w1.x = cvt_pk_bf16(p1[8 * s + 0], p1[8 * s + 1]); w1.y = cvt_pk_bf16(p1[8 * s + 2], p1[8 * s + 3]); w1.z = cvt_pk_bf16(p1[8 * s + 4], p1[8 * s + 5]); w1.w = cvt_pk_bf16(p1[8 * s + 6], p1[8 * s + 7]);
        const bf16x8 b0 = __builtin_bit_cast(bf16x8, w0), b1 = __builtin_bit_cast(bf16x8, w1);
        o0 = MF32(LDF(tb + WN_VT + vo[s]), b0, o0); o1 = MF32(LDF(tb + WN_VT + vo[s] + 4096), b0, o1);
        o0 = MF32(LDF(tb + WN_VT + vo[2 + s]), b1, o0); o1 = MF32(LDF(tb + WN_VT + vo[2 + s] + 4096), b1, o1);
    }
}
constexpr int WN_NCH = 1;
__device__ __forceinline__ void win_phase(LAS unsigned char* lds, unsigned* winq, const bf16_t* Qa, const bf16_t* Ka, const bf16_t* VaT, const float* sink, bf16_t* attn_out, float* ssq_a) {
    const int tid = threadIdx.x, lane = tid & 63, r32 = lane & 31, hi = lane >> 5, wv = __builtin_amdgcn_readfirstlane(tid >> 6), hh = wv & 3, sub = wv >> 2;
    const int pr = (r32 & ~12) | ((r32 & 4) << 1) | ((r32 & 8) >> 1);
    int kon[4], vo[4];
#pragma unroll
    for (int d0 = 0; d0 < 4; ++d0) kon[d0] = pr * 128 + (((2 * d0 + hi) ^ ((pr >> 1) & 7)) << 4);
#pragma unroll
    for (int k = 0; k < 4; ++k) vo[k] = r32 * 128 + (((2 * k + hi) ^ ((r32 >> 1) & 7)) << 4);
    const int drow = 8 * wv + (lane >> 3), dlg = (lane & 7) ^ ((drow >> 1) & 7), dsrc = drow * 64 + dlg * 8;
    LAS int* claim = (LAS int*)(lds + MISC_OFF + 128);
    for (;;) {
        __syncthreads();
        if (tid == 0) *claim = (int)atomicAdd(winq, 1u);
        __syncthreads();
        const int su = __builtin_amdgcn_readfirstlane(*claim);
        if (su >= 4 * (256 / WN_NCH)) break;
        const int bk = su / (256 / WN_NCH), b = bk >> 1, kvh = bk & 1, j0 = (su % (256 / WN_NCH)) * WN_NCH;
        const bf16_t* Kt = Ka + (size_t)bk * S * 64; const bf16_t* Vt = VaT + (size_t)bk * S * 64;
#pragma unroll
        for (int i = 0; i < WN_NCH + 4; ++i) { const int tile = j0 - 2 + i;
            if (tile >= 0 && tile < S / 64) {
                __builtin_amdgcn_global_load_lds((const unsigned*)(Kt + (size_t)tile * 4096 + dsrc), (LAS unsigned*)(lds + i * WN_TILE + wv * 1024), 16, 0, 0);
                __builtin_amdgcn_global_load_lds((const unsigned*)(Vt + (size_t)tile * 4096 + dsrc), (LAS unsigned*)(lds + i * WN_TILE + WN_VT + wv * 1024), 16, 0, 0);
            } }
        asm volatile("s_waitcnt vmcnt(0)" ::: "memory");
        __syncthreads();
        const int hd = kvh * 4 + hh; const float sink_l2 = sink[hd] * LOG2E;
        for (int u = 0; u < WN_NCH; ++u) {
            const int j = j0 + u, qw = 64 * j + 32 * sub;
            const bf16_t* Qw = Qa + ((size_t)b * S + qw) * 512 + hd * 64;
            bf16x8 q[4];
#pragma unroll
            for (int d0 = 0; d0 < 4; ++d0) q[d0] = *(const bf16x8*)(Qw + (size_t)r32 * 512 + d0 * 16 + hi * 8);
            float mrun = -1e30f, lrun = 0.f; f32x16 o0, o1;
#pragma unroll
            for (int r = 0; r < 16; ++r) { o0[r] = 0.f; o1[r] = 0.f; }
#pragma unroll
            for (int rel = -2; rel <= 2; ++rel) { const int tile = j + rel;
                if (tile >= 0 && tile < S / 64) { const LAS unsigned char* tb = lds + (u + rel + 2) * WN_TILE; const int dj = tile * 64 + 8 * hi - (qw + r32);
                    if (rel == -2 || rel == 2) win_tile<true>(tb, kon, vo, q, o0, o1, mrun, lrun, dj); else win_tile<false>(tb, kon, vo, q, o0, o1, mrun, lrun, dj); } }
            float ltot = lrun + __shfl_xor(lrun, 32);
            { const float mf = fmaxf(mrun, sink_l2), a = __builtin_amdgcn_exp2f(mrun - mf); ltot = ltot * a + __builtin_amdgcn_exp2f(sink_l2 - mf);
              const float inv = a / ltot; float qs = 0.f;
#pragma unroll
              for (int r = 0; r < 16; ++r) { o0[r] *= inv; o1[r] *= inv; qs += o0[r] * o0[r] + o1[r] * o1[r]; }
              qs += __shfl_xor(qs, 32);
              if (hi == 0) atomicAdd(ssq_a + (size_t)b * S + qw + r32, qs); }
            bf16_t* orow = attn_out + ((size_t)b * S + qw + r32) * D + hd * 64 + 4 * hi;
#pragma unroll
            for (int g = 0; g < 4; ++g) {
                u32x2 w0, w1; w0.x = cvt_pk_bf16(o0[4 * g], o0[4 * g + 1]); w0.y = cvt_pk_bf16(o0[4 * g + 2], o0[4 * g + 3]); w1.x = cvt_pk_bf16(o1[4 * g], o1[4 * g + 1]); w1.y = cvt_pk_bf16(o1[4 * g + 2], o1[4 * g + 3]);
                *(u32x2*)(orow + 8 * g) = w0; *(u32x2*)(orow + 32 + 8 * g) = w1;
            }
        }
    }
}

struct Args { const float* in[24]; const int* pos; float* out; unsigned char* ws; int ph_lo, ph_hi; };

struct ConvDesc { const float* colptr; size_t ldw; const float* ga; const float* gb; int gsplit, k0, K; bf16_t* dst; };
__device__ __forceinline__ void conv_load(const ConvDesc& d, float (&v)[32], int lane) {
    const float* p0 = d.colptr + (size_t)(d.k0 + (lane >> 5)) * d.ldw;
#pragma unroll
    for (int i = 0; i < 32; ++i) v[i] = d.colptr ? __builtin_nontemporal_load(p0 + (size_t)(2 * i) * d.ldw) : 0.f;
}
__device__ __forceinline__ void conv_store(const ConvDesc& d, float (&v)[32], LAS float* scr, int lane) {
    if (d.ga) {
#pragma unroll
        for (int i = 0; i < 32; ++i) { const int k = d.k0 + 2 * i + (lane >> 5); v[i] *= (k < d.gsplit ? d.ga[k] : d.gb[k - d.gsplit]); }
    }
#pragma unroll
    for (int i = 0; i < 32; ++i) scr[(2 * i + (lane >> 5)) * 33 + (lane & 31)] = v[i];
    asm volatile("s_waitcnt lgkmcnt(0)" ::: "memory");
    const int c = lane & 7;
#pragma unroll
    for (int j = 0; j < 4; ++j) { const int n = (lane >> 3) + 8 * j; const LAS float* s = scr + (8 * c) * 33 + n;
        u32x4 o; o.x = cvt_pk_bf16(s[0 * 33], s[1 * 33]); o.y = cvt_pk_bf16(s[2 * 33], s[3 * 33]); o.z = cvt_pk_bf16(s[4 * 33], s[5 * 33]); o.w = cvt_pk_bf16(s[6 * 33], s[7 * 33]);
        *(u32x4*)(d.dst + (size_t)n * d.K + d.k0 + 8 * c) = o; }
    asm volatile("s_waitcnt lgkmcnt(0)" ::: "memory");
}
__device__ __forceinline__ int pairperm(int p, int half) {
    const int a = p >> 3, b = p & 7; return b < 4 ? 4 * a + b : half + 4 * a + (b - 4);
}

__global__ void __launch_bounds__(NWAVES * 64, 2) fwd_kernel(Args args) {
    extern __shared__ __attribute__((aligned(16))) unsigned char lds_raw[];
    LAS unsigned char* lds = (LAS unsigned char*)lds_raw;
    volatile LAS unsigned* MISC = (volatile LAS unsigned*)(lds + MISC_OFF);
    const int tid = threadIdx.x, lane = tid & 63, wave = __builtin_amdgcn_readfirstlane(tid >> 6);
    const int G = gridDim.x; const int bx = blockIdx.x; const int vcu = (G % 8 == 0) ? (bx % 8) * (G / 8) + bx / 8 : bx;
    unsigned char* ws = args.ws;
    unsigned* ctl = (unsigned*)(ws + WS_CTL);
    float* ctlf = (float*)(ws + WS_CTL);
    for (int u = tid; u < (LDS_BYTES - MISC_OFF) / 4; u += NWAVES * 64) ((LAS unsigned*)(lds + MISC_OFF))[u] = 0u;
    __syncthreads();
    XcdBarrier bar; bar.bar = ctl + CW_BAR; bar.x = 0; bar.st = nullptr;
    if (N_LAUNCHES == 1) bar = xcd_barrier_post(ctl + CW_BAR, MISC + 8);
    const int lo = args.ph_lo, hi_ph = args.ph_hi;
#ifndef PHMASK
#define PHMASK 0x1ff
#endif
#define IN(k) (((PHMASK >> (k)) & 1) && lo <= (k) && (k) < hi_ph)
#define SEAM(k) do { if (IN(k) && IN((k) + 1)) xcd_barrier(bar); } while (0)
    const int gw = vcu * NWAVES + wave, NGW = G * NWAVES;

    const float* x = args.in[0];
    bf16_t* W1t = (bf16_t*)(ws + WS_W1T); bf16_t* W2q = (bf16_t*)(ws + WS_W2Q); bf16_t* W2kv = (bf16_t*)(ws + WS_W2KV); bf16_t* W4t = (bf16_t*)(ws + WS_W4T);
    bf16_t* Wgu = (bf16_t*)(ws + WS_WGU); bf16_t* Wd = (bf16_t*)(ws + WS_WD); bf16_t* Wrt = (bf16_t*)(ws + WS_WRT);
    float* cosA = (float*)(ws + WS_COSA); float* sinA = (float*)(ws + WS_SINA); float* cosB = (float*)(ws + WS_COSB); float* sinB = (float*)(ws + WS_SINB);
    float* xstat = (float*)(ws + WS_XSTAT);
    bf16_t* h0b = (bf16_t*)(ws + WS_H0B); bf16_t* attn_out = (bf16_t*)(ws + WS_H0B); bf16_t* h1b = (bf16_t*)(ws + WS_H0B);
    bf16_t* cq = (bf16_t*)(ws + WS_CQ); bf16_t* hid = (bf16_t*)(ws + WS_CQ); bf16_t* ckv = (bf16_t*)(ws + WS_CKV);
    bf16_t* Qa = (bf16_t*)(ws + WS_QA); bf16_t* Ka = (bf16_t*)(ws + WS_KA); bf16_t* VaT = (bf16_t*)(ws + WS_VAT); bf16_t* Kr = (bf16_t*)(ws + WS_KR);
    bf16_t* Qb = (bf16_t*)(ws + WS_QB); bf16_t* Kn = (bf16_t*)(ws + WS_KN); bf16_t* VbT = (bf16_t*)(ws + WS_VBT); unsigned char* Qn8 = ws + WS_KN + 16 * MiB;
    bf16_t* h1pre = (bf16_t*)(ws + WS_H1PRE); bf16_t* ysl = (bf16_t*)(ws + WS_Y);
    unsigned* ltok = (unsigned*)(ws + WS_LTOK); float* lw = (float*)(ws + WS_LW);
    float* ssq_q = ctlf + CW_SSQ_Q; float* ssq_kv = ctlf + CW_SSQ_KV; float* ssq_a = ctlf + CW_SSQ_A; float* ssq_b = ctlf + CW_SSQ_B; float* s1 = ctlf + CW_S1; float* s2 = ctlf + CW_S2;

    constexpr int I0 = 16 * 64, I1 = 12 * 24, I2 = 4 * 32, I3 = 16 * 32, I4 = 32 * 256, I5 = 32 * 128, I6 = 16 * 2;
    constexpr int NITEMS = I0 + I1 + I2 + I3 + I4 + I5 + I6;
    const int nn = lane & 31;
    auto decode = [&](int r, ConvDesc& d) {
        d.ga = nullptr; d.gb = nullptr; d.gsplit = 0;
        if (r < I0) {
            const int kb = r / 64, nb = r % 64, n = nb * 32 + nn; int src;
            if (n < 640) src = (n & ~63) + pairperm(n & 63, 32); else if (n < 1792) src = n; else if (n < 1824) src = 1792 + pairperm(n - 1792, 16); else src = -1;
            d.colptr = src >= 0 ? args.in[4] + src : nullptr; d.ldw = IN_COLS; d.k0 = kb * 64; d.K = 1024; d.dst = W1t + (size_t)(nb * 32) * 1024; return; } r -= I0;
        if (r < I1) {
            const int kb = r / 24, nb = r % 24, n = nb * 32 + nn; int src;
            if (n < 512) src = (n >> 6) * 96 + (n & 63); else { const int hd = (n - 512) >> 5, p = (n - 512) & 31; src = hd * 96 + 64 + pairperm(p, 16); }
            d.colptr = args.in[7] + src; d.ldw = 768; d.ga = args.in[6]; d.gb = args.in[6]; d.gsplit = 1 << 30; d.k0 = kb * 64; d.K = 768; d.dst = W2q + (size_t)(nb * 32) * 768; return; } r -= I1;
        if (r < I2) {
            const int kb = r / 32, nb = r % 32, n = nb * 32 + nn; const int src = (n < 512) ? (n >> 6) * 128 + (n & 63) : ((n - 512) >> 6) * 128 + 64 + (n & 63);
            d.colptr = args.in[9] + src; d.ldw = 1024; d.ga = args.in[8]; d.gb = args.in[8]; d.gsplit = 1 << 30; d.k0 = kb * 64; d.K = 256; d.dst = W2kv + (size_t)(nb * 32) * 256; return; } r -= I2;
        if (r < I3) {
            const int kb = r / 32, nb = r % 32, n = nb * 32 + nn;
            d.colptr = args.in[12] + n; d.ldw = 1024; d.ga = args.in[10]; d.gb = args.in[11]; d.gsplit = 512; d.k0 = kb * 64; d.K = 1024; d.dst = W4t + (size_t)(nb * 32) * 1024; return; } r -= I3;
        if (r < I4) {
            const int e = r / 256, r2 = r % 256, kb = r2 / 16, nb = r2 % 16, n = nb * 32 + nn, qq = n >> 8, j = n & 255;
            d.colptr = (j < 128) ? args.in[19] + (size_t)e * 1024 * 256 + 128 * qq + j : args.in[20] + (size_t)e * 1024 * 256 + 128 * qq + (j - 128);
            d.ldw = 256; d.k0 = kb * 64; d.K = 1024; d.dst = Wgu + ((size_t)e * 512 + nb * 32) * 1024; return; } r -= I4;
        if (r < I5) {
            const int e = r / 128, r2 = r % 128, kb = r2 / 32, nb = r2 % 32, n = nb * 32 + nn;
            d.colptr = args.in[21] + (size_t)e * 256 * 1024 + n; d.ldw = 1024; d.k0 = kb * 64; d.K = 256; d.dst = Wd + ((size_t)e * 1024 + nb * 32) * 256; return; } r -= I5;
        {
            const int kb = r / 2, nb = r % 2, n = nb * 32 + nn;
            d.colptr = (n < 4) ? args.in[15] + n : (n < 36) ? args.in[17] + (n - 4) : nullptr; d.ldw = (n < 4) ? 4 : 32; d.k0 = kb * 64; d.K = 1024; d.dst = Wrt + (size_t)(nb * 32) * 1024;
        }
    };
#define CONV_RUN(n_, w_, nw_, MAP, scrp) do { ConvDesc dA, dB; float vA[32], vB[32]; int it = (w_); \
        if (it < (n_)) { decode(MAP(it), dA); conv_load(dA, vA, lane); } \
        while (it < (n_)) { const int itB = it + (nw_); \
            if (itB < (n_)) { decode(MAP(itB), dB); conv_load(dB, vB, lane); } \
            conv_store(dA, vA, (scrp), lane); \
            if (itB >= (n_)) break; \
            const int itA = itB + (nw_); \
            if (itA < (n_)) { decode(MAP(itA), dA); conv_load(dA, vA, lane); } \
            conv_store(dB, vB, (scrp), lane); \
            it = itA; } } while (0)
#define CONV_MAP_P0(i) ((i) < I0 + I1 + I2 + I3 ? (i) : (i) + I4 + I5)
#define CONV_MAP_MOE(i) ((i) + I0 + I1 + I2 + I3)
    if (IN(0)) {
        LAS float* scr = (LAS float*)(lds + wave * 16384);
        CONV_RUN(I0 + I1 + I2 + I3 + I6, gw, NGW, CONV_MAP_P0, scr);
        {
            const int j = lane & 31; const float inv = 1.0f / powf(10000.0f, (float)(2 * j) / 64.0f);
            for (int i = gw * 64 + lane; i < T * 32; i += NGW * 64) {
                const int tok = i >> 5; const float ang = (float)args.pos[tok] * inv;
                const double rev = (double)ang * 0.15915494309189535; const float fr = (float)(rev - rint(rev));
                const float cs = __builtin_amdgcn_cosf(fr), sn = __builtin_amdgcn_sinf(fr);
                cosA[(size_t)tok * 32 + j] = cs; sinA[(size_t)tok * 32 + j] = sn;
                if ((j & 1) == 0) { cosB[(size_t)tok * 16 + (j >> 1)] = cs; sinB[(size_t)tok * 16 + (j >> 1)] = sn; }
            }
        }
        {
            f32x4 g[4], bb[4];
#pragma unroll
            for (int j = 0; j < 4; ++j) { g[j] = *(const f32x4*)(args.in[2] + 4 * lane + 256 * j); bb[j] = *(const f32x4*)(args.in[3] + 4 * lane + 256 * j); }
            for (int row0 = gw * 4; row0 < T; row0 += NGW * 4) {
                f32x4 v[4][4]; float s[4], q[4];
#pragma unroll
                for (int r = 0; r < 4; ++r) { const f32x4* xr = (const f32x4*)(x + (size_t)(row0 + r) * D) + lane;
#pragma unroll
                    for (int j = 0; j < 4; ++j) v[r][j] = __builtin_nontemporal_load(xr + 64 * j); }
#pragma unroll
                for (int r = 0; r < 4; ++r) { s[r] = 0.f;
#pragma unroll
                    for (int j = 0; j < 4; ++j) s[r] += (v[r][j][0] + v[r][j][1]) + (v[r][j][2] + v[r][j][3]); }
#pragma unroll
                for (int o = 1; o < 64; o <<= 1) {
#pragma unroll
                    for (int r = 0; r < 4; ++r) s[r] += __shfl_xor(s[r], o); }
#pragma unroll
                for (int r = 0; r < 4; ++r) { s[r] *= (1.f / D); q[r] = 0.f;
#pragma unroll
                    for (int j = 0; j < 4; ++j) { v[r][j] = v[r][j] - s[r]; q[r] += sq4(v[r][j]); } }
#pragma unroll
                for (int o = 1; o < 64; o <<= 1) {
#pragma unroll
                    for (int r = 0; r < 4; ++r) q[r] += __shfl_xor(q[r], o); }
#pragma unroll
                for (int r = 0; r < 4; ++r) { const float rstd = fast_rsqrt(q[r] * (1.f / D) + LN_EPS);
                    u32x2* o8 = (u32x2*)(h0b + (size_t)(row0 + r) * D) + lane;
#pragma unroll
                    for (int j = 0; j < 4; ++j) { const f32x4 y = v[r][j] * rstd * g[j] + bb[j]; u32x2 w; w.x = cvt_pk_bf16(y[0], y[1]); w.y = cvt_pk_bf16(y[2], y[3]); o8[64 * j] = w; }
                    if (lane == 0) { xstat[2 * (row0 + r)] = s[r]; xstat[2 * (row0 + r) + 1] = rstd; } }
            }
        }
    }
    SEAM(0);
    if (IN(1)) {
        pg8::DenseSched<D> Sd; Sd.init(h0b, W1t, T, N1, G, bx);
        Epi1 E{Qa, Ka, VaT, cq, ckv, Kr, ssq_q, ssq_kv, cosA, sinA, cosB, sinB, ctl + CW_KR2};
        pg8::gemm_phase<Epi1, pg8::DenseSched<D>, true, D>(lds, Sd, E);
    }
    SEAM(1);
    if (IN(2)) {
        { pg8::DenseSched<768> Sd; Sd.init(cq, W2q, T, 768, G, bx); Epi2q E{Qb, Qn8, ssq_q, cosB, sinB}; pg8::gemm_phase<Epi2q, pg8::DenseSched<768>, true, 768>(lds, Sd, E); }
        __syncthreads();
        { pg8::DenseSched<256> Sd; Sd.init(ckv, W2kv, T, 1024, G, bx); Epi2kv E{Kn, VbT, ssq_kv, ctl + CW_KN2}; pg8::gemm_phase<Epi2kv, pg8::DenseSched<256>, true, 256>(lds, Sd, E); }
    }
    SEAM(2);
    if (IN(3)) {
        for (int u = vcu; u < 512; u += G) {
            const int bh = u >> 5, b = bh >> 3, hd = bh & 7, q0 = (u & 31) * 512;
            const MlaSrc cs{(const bf16_t*)((const unsigned char*)Kn + (size_t)bh * S * 64), (const bf16_t*)((const unsigned char*)Kr + (size_t)b * S * 32), VbT + (size_t)bh * S * 64};
            float kn_bound, kr_bound;
            { const int pmi = b * (S / 256) + lane; unsigned m0 = ctl[CW_KN2 + (pmi * 8 + hd) * 2], m1 = ctl[CW_KN2 + (pmi * 8 + hd) * 2 + 1], mr = ctl[CW_KR2 + pmi];
#pragma unroll
              for (int o = 1; o < 64; o <<= 1) { const unsigned a0 = __shfl_xor(m0, o), a1 = __shfl_xor(m1, o), ar = __shfl_xor(mr, o); m0 = m0 > a0 ? m0 : a0; m1 = m1 > a1 ? m1 : a1; mr = mr > ar ? mr : ar; }
              kn_bound = sqrtf(__uint_as_float(m0) + __uint_as_float(m1)) * 1.01f; kr_bound = sqrtf(__uint_as_float(mr)) * 1.01f; }
            mla8_unit(lds, (const unsigned char*)Qb + ((size_t)b * S + q0) * 256 + hd * 32, Qn8 + ((size_t)b * S + q0) * 512 + hd * 64, cs, kn_bound, kr_bound, attn_out + ((size_t)b * S + q0) * D + 512 + hd * 64, ssq_b + (size_t)b * S + q0);
        }
        win_phase(lds, ctl + CW_WINQ, Qa, Ka, VaT, args.in[5], attn_out, ssq_a);
        __syncthreads();
    }
    SEAM(3);
    if (IN(4)) {
        pg8::DenseSched<D> Sd; Sd.init(attn_out, W4t, T, D, G, bx);
        Epi4 E{x, xstat, args.in[2], args.in[3], ssq_a, ssq_b, h1pre, s1, s2};
        pg8::gemm_phase<Epi4, pg8::DenseSched<D>, true, D>(lds, Sd, E);
    }
    SEAM(4);
    if (IN(5)) {
        LAS unsigned char* wl = lds + wave * 16896;
        constexpr int NCV_HI = (I4 + I5) / 4 * 3;
        if (wave >= 4) { CONV_RUN(NCV_HI, (wave - 4) * G + vcu, 4 * G, CONV_MAP_MOE, (LAS float*)wl); }
        const int r32 = lane & 31, hi = lane >> 5;
        for (int grp = wave * G + vcu; grp < T / 32; grp += NGW) {
            const int row0 = grp * 32;
            float mu_l, rs_l;
            { const float a = s1[row0 + r32] * (1.f / D), bq = s2[row0 + r32] * (1.f / D); mu_l = a; rs_l = fast_rsqrt(fmaxf(bq - a * a, 0.f) + LN_EPS); }
            f32x16 a0, a1;
#pragma unroll
            for (int r = 0; r < 16; ++r) { a0[r] = 0.f; a1[r] = 0.f; }
            for (int c = 0; c < 4; ++c) {
                const int col = 256 * c + 4 * lane;
                const bf16_t* wb0 = Wrt + (size_t)r32 * 1024 + 256 * c + 8 * hi; const bf16_t* wb1 = wb0 + 32 * 1024;
                bf16x8 blo[16];
#pragma unroll
                for (int ks = 0; ks < 8; ++ks) { blo[2 * ks] = *(const bf16x8*)(wb0 + 16 * ks); blo[2 * ks + 1] = *(const bf16x8*)(wb1 + 16 * ks); }
                const f32x4 g = *(const f32x4*)(args.in[13] + col), bb = *(const f32x4*)(args.in[14] + col);
                __builtin_amdgcn_sched_barrier(0);
                bf16x8 bhi[16];
                { u32x2 hv[32];
                  const bf16_t* rp = h1pre + (size_t)row0 * D + col;
#pragma unroll
                  for (int r = 0; r < 32; ++r) hv[r] = *(const u32x2*)(rp + (size_t)r * D);
                  __builtin_amdgcn_sched_barrier(0);
                  bf16_t* wp = h1b + (size_t)row0 * D + col;
#pragma unroll
                  for (int r = 0; r < 32; ++r) {
                    if (r == 16) {
                        __builtin_amdgcn_sched_barrier(0);
#pragma unroll
                        for (int ks = 8; ks < 12; ++ks) { bhi[2 * (ks - 8)] = *(const bf16x8*)(wb0 + 16 * ks); bhi[2 * (ks - 8) + 1] = *(const bf16x8*)(wb1 + 16 * ks); }
                        __builtin_amdgcn_sched_barrier(0); }
                    const float mu = __shfl(mu_l, r), rs = __shfl(rs_l, r);
                    const f32x4 v = (f32x4){bf_lo(hv[r].x), bf_hi(hv[r].x), bf_lo(hv[r].y), bf_hi(hv[r].y)};
                    const f32x4 y = (v - mu) * rs * g + bb;
                    u32x2 w; w.x = cvt_pk_bf16(y[0], y[1]); w.y = cvt_pk_bf16(y[2], y[3]);
                    *(u32x2*)(wp + (size_t)r * D) = w;
                    *(LAS u32x2*)(wl + r * 528 + lane * 8) = w;
                  } }
                __builtin_amdgcn_sched_barrier(0);
#pragma unroll
                for (int ks = 12; ks < 16; ++ks) { bhi[2 * (ks - 8)] = *(const bf16x8*)(wb0 + 16 * ks); bhi[2 * (ks - 8) + 1] = *(const bf16x8*)(wb1 + 16 * ks); }
                __builtin_amdgcn_sched_barrier(0);
#pragma unroll
                for (int ks = 0; ks < 8; ++ks) {
                    const bf16x8 af = *(const LAS bf16x8*)(wl + r32 * 528 + (16 * ks + 8 * hi) * 2);
                    a0 = __builtin_amdgcn_mfma_f32_32x32x16_bf16(af, blo[2 * ks], a0, 0, 0, 0);
                    a1 = __builtin_amdgcn_mfma_f32_32x32x16_bf16(af, blo[2 * ks + 1], a1, 0, 0, 0);
                }
#pragma unroll
                for (int ks = 8; ks < 16; ++ks) {
                    const bf16x8 af = *(const LAS bf16x8*)(wl + r32 * 528 + (16 * ks + 8 * hi) * 2);
                    a0 = __builtin_amdgcn_mfma_f32_32x32x16_bf16(af, bhi[2 * (ks - 8)], a0, 0, 0, 0);
                    a1 = __builtin_amdgcn_mfma_f32_32x32x16_bf16(af, bhi[2 * (ks - 8) + 1], a1, 0, 0, 0);
                }
            }
            LAS float* sl = (LAS float*)wl;
#pragma unroll
            for (int r = 0; r < 16; ++r) { const int rowr = (r & 3) + 8 * (r >> 2) + 4 * hi; sl[rowr * 40 + r32] = a0[r]; if (r32 < 4) sl[rowr * 40 + 32 + r32] = a1[r]; }
            asm volatile("s_waitcnt lgkmcnt(0)" ::: "memory");
            if (lane < 32) {
                const int tok = row0 + lane; const LAS float* lr = sl + lane * 40;
                float gl[4];
#pragma unroll
                for (int j = 0; j < 4; ++j) gl[j] = lr[j] + args.in[16][j];
                int gi = 0; float gm = gl[0];
#pragma unroll
                for (int j = 1; j < 4; ++j) if (gl[j] > gm) { gm = gl[j]; gi = j; }
                float gs = 0.f;
#pragma unroll
                for (int j = 0; j < 4; ++j) gs += __expf(gl[j] - gm);
                const float pg = 1.0f / gs;
                float el[8];
#pragma unroll
                for (int j = 0; j < 8; ++j) el[j] = lr[4 + 8 * gi + j] + args.in[18][8 * gi + j];
                int i1 = 0; float v1 = el[0];
#pragma unroll
                for (int j = 1; j < 8; ++j) if (el[j] > v1) { v1 = el[j]; i1 = j; }
                int i2 = (i1 == 0) ? 1 : 0; float v2 = (i1 == 0) ? el[1] : el[0];
#pragma unroll
                for (int j = 1; j < 8; ++j) if (j != i1 && el[j] > v2) { v2 = el[j]; i2 = j; }
                const float tt = __expf(v2 - v1), w1 = pg / (1.0f + tt), w2 = pg * tt / (1.0f + tt);
                const int e1 = 8 * gi + i1, e2 = 8 * gi + i2;
                const unsigned p1 = atomicAdd(ctl + CW_ECNT + 64 * e1, 1u); ltok[(size_t)e1 * T + p1] = (unsigned)tok; lw[(size_t)e1 * T + p1] = w1;
                const unsigned p2 = atomicAdd(ctl + CW_ECNT + 64 * e2, 1u); ltok[(size_t)e2 * T + p2] = (unsigned)tok | 0x8000u; lw[(size_t)e2 * T + p2] = w2;
            }
            asm volatile("s_waitcnt lgkmcnt(0)" ::: "memory");
        }
#define CONV_MAP_MOE_LO(i) ((i) + I0 + I1 + I2 + I3 + NCV_HI)
        if (wave < 4) { CONV_RUN(I4 + I5 - NCV_HI, wave * G + vcu, 4 * G, CONV_MAP_MOE_LO, (LAS float*)wl); }
        __syncthreads();
    }
    SEAM(5);
    LAS int* tab = (LAS int*)(lds + MISC_OFF + 256);
    if (IN(6) || IN(7)) {
        if (tid < 32) { const int c = (int)__hip_atomic_load(ctl + CW_ECNT + 64 * tid, RLX_AGENT); tab[64 + tid] = c; tab[128 + tid] = (c + 255) >> 8; }
        __syncthreads();
        if (tid == 0) { int acc = 0; for (int e = 0; e < 32; ++e) { tab[e] = acc; acc += tab[128 + e]; } tab[32] = acc; }
        __syncthreads();
    }
    const bool owns = (IN(6) && IN(7)) ? (tab[32] >= G && 2 * (tab[32] - G) <= G) : false;
    if (IN(6)) {
        MoeSched<0> Sm{tab, h1b, Wgu, ltok, G, owns ? vcu : bx, 2, owns ? 1 : 0};
        EpiGU E{hid};
        pg8::gemm_phase<EpiGU, MoeSched<0>, true, D>(lds, Sm, E);
    }
#pragma nounroll
    for (int ps = owns ? 0 : 1; ps < 2; ++ps) {
        if (ps == 0) { asm volatile("s_waitcnt vmcnt(0)" ::: "memory"); __syncthreads(); }
        else SEAM(6);
        if (IN(7)) {
            MoeSched<1> Sm{tab, hid, Wd, ltok, G, owns ? vcu : bx, 4, owns ? 2 + ps : 0};
            EpiD E{ltok, lw, ysl};
            pg8::gemm_phase<EpiD, MoeSched<1>, true, EFF>(lds, Sm, E);
        }
    }
    SEAM(7);
    if (IN(8)) {
        f32x4 g1[4], b1[4], g2[4], b2[4];
#pragma unroll
        for (int j = 0; j < 4; ++j) { const int col = 4 * lane + 256 * j; g1[j] = *(const f32x4*)(args.in[13] + col); b1[j] = *(const f32x4*)(args.in[14] + col); g2[j] = *(const f32x4*)(args.in[22] + col); b2[j] = *(const f32x4*)(args.in[23] + col); }
        for (int row = gw; row < T; row += NGW) {
            const float mu1 = s1[row] * (1.f / D), rs1 = fast_rsqrt(fmaxf(s2[row] * (1.f / D) - mu1 * mu1, 0.f) + LN_EPS);
            f32x4 v[4]; float s = 0.f;
#pragma unroll
            for (int j = 0; j < 4; ++j) { const int col = 4 * lane + 256 * j;
                const u32x2 hv = __builtin_nontemporal_load((const u32x2*)(h1pre + (size_t)row * D + col)); const f32x4 hp = (f32x4){bf_lo(hv.x), bf_hi(hv.x), bf_lo(hv.y), bf_hi(hv.y)};
                const u32x2 ya = __builtin_nontemporal_load((const u32x2*)(ysl + (size_t)row * D + col)), yb = __builtin_nontemporal_load((const u32x2*)(ysl + (size_t)T * D + (size_t)row * D + col));
                const f32x4 h1 = (hp - mu1) * rs1 * g1[j] + b1[j];
                f32x4 y; y[0] = bf_lo(ya.x) + bf_lo(yb.x); y[1] = bf_hi(ya.x) + bf_hi(yb.x); y[2] = bf_lo(ya.y) + bf_lo(yb.y); y[3] = bf_hi(ya.y) + bf_hi(yb.y);
                v[j] = h1 * DN_ALPHA + y; s += (v[j][0] + v[j][1]) + (v[j][2] + v[j][3]); }
            const float mean = wave_sum(s) * (1.f / D); float q = 0.f;
#pragma unroll
            for (int j = 0; j < 4; ++j) { v[j] = v[j] - mean; q += sq4(v[j]); }
            const float rstd = fast_rsqrt(wave_sum(q) * (1.f / D) + LN_EPS);
#pragma unroll
            for (int j = 0; j < 4; ++j) __builtin_nontemporal_store(v[j] * rstd * g2[j] + b2[j], (f32x4*)(args.out + (size_t)row * D + 4 * lane + 256 * j));
        }
    }
#undef IN
#undef SEAM
}

extern "C" void kernel_launch(void* const* d_in, const int* in_sizes, int n_in, void* d_out, int out_size, void* d_ws, size_t ws_size, hipStream_t stream) {
    static int grid = 0;
    if (grid == 0) {
        if (n_in != 24 || in_sizes[0] != T * D || out_size != T * D || ws_size < WS_END) { fprintf(stderr, "kernel_launch: unexpected shapes (n_in %d, in0 %d, out %d, ws %zu)\n", n_in, n_in > 0 ? in_sizes[0] : -1, out_size, ws_size); grid = -1; return; }
        int dev = 0, cus = 0, per_cu = 0;
        if (hipGetDevice(&dev) != hipSuccess || hipDeviceGetAttribute(&cus, hipDeviceAttributeMultiprocessorCount, dev) != hipSuccess) { grid = -1; return; }
        if (hipFuncSetAttribute((const void*)fwd_kernel, hipFuncAttributeMaxDynamicSharedMemorySize, LDS_BYTES) != hipSuccess) { fprintf(stderr, "kernel_launch: hipFuncSetAttribute failed\n"); grid = -1; return; }
        if (hipOccupancyMaxActiveBlocksPerMultiprocessor(&per_cu, (const void*)fwd_kernel, NWAVES * 64, LDS_BYTES) != hipSuccess || per_cu < 1)
            fprintf(stderr, "kernel_launch: note: occupancy query reports %d workgroups per CU\n", per_cu);
        (void)hipGetLastError();
        grid = cus;
    }
    if (grid < 0) return;
    if (hipMemsetAsync((char*)d_ws + WS_CTL, 0, CTL_ZERO_BYTES, stream) != hipSuccess) return;
    Args a{};
    for (int i = 0; i < 24; ++i) a.in[i] = (const float*)d_in[i];
    a.pos = (const int*)d_in[1]; a.out = (float*)d_out; a.ws = (unsigned char*)d_ws;
    if (N_LAUNCHES == 1) { a.ph_lo = 0; a.ph_hi = N_PHASES; hipLaunchKernelGGL(fwd_kernel, dim3(grid), dim3(NWAVES * 64), LDS_BYTES, stream, a); }
    else for (int p = 0; p < N_PHASES; ++p) { a.ph_lo = p; a.ph_hi = p + 1; hipLaunchKernelGGL(fwd_kernel, dim3(grid), dim3(NWAVES * 64), LDS_BYTES, stream, a); }
}
```
